# Optimizing an MI355X kernel written in HIP

```python
import math
import jax, jax.numpy as jnp
from jax import lax
import numpy as np

D_MODEL = 1024
BATCH = 8
SEQ = 4096
DEPTH = 2

D_MIX = D_MODEL
SGU_GROUPS = 8
SGU_GROUP_DIM = 64
SGU_WIDTH = SGU_GROUPS * SGU_GROUP_DIM
CHUNK = 128
MLA_HEADS = 4
QK_NOPE = 128
QK_ROPE = 64
QK_HEAD = QK_NOPE + QK_ROPE
V_HEAD = 128
MLA_WIDTH = MLA_HEADS * V_HEAD
Q_LORA = 256
KV_LORA = 128
D_IN = 2 * SGU_WIDTH + Q_LORA + KV_LORA + QK_ROPE
IN_SPLITS = (SGU_WIDTH, 2 * SGU_WIDTH, 2 * SGU_WIDTH + Q_LORA, 2 * SGU_WIDTH + Q_LORA + KV_LORA)
ROPE_BASE = 10000.0
Q_BLOCK = 128
D_FF = 2816
N_EXPERTS = 8
TOP_K = 2
D_FF_EXPERT = 2816
N_MOD = 6
EPS = 1e-6
N_DENSE_LAYERS = (DEPTH + 1) // 2
N_MOE_LAYERS = DEPTH // 2

kernel_name = "hybrid_sgu_mla_moe_adaln"


def rms_norm(x, g):
    xf = x.astype(jnp.float32)
    y = xf * lax.rsqrt(jnp.mean(xf * xf, axis=-1, keepdims=True) + EPS)
    return (y * g.astype(jnp.float32)).astype(x.dtype)


def layer_norm(x, g):
    xf = x.astype(jnp.float32)
    mu = jnp.mean(xf, axis=-1, keepdims=True)
    var = jnp.mean(jnp.square(xf - mu), axis=-1, keepdims=True)
    y = (xf - mu) * lax.rsqrt(var + EPS)
    return (y * g.astype(jnp.float32)).astype(x.dtype)


def modulate(h, shift, scale):
    return h * (1 + scale[:, None, :]) + shift[:, None, :]


def rope_tables(positions):
    inv_freq = 1.0 / (ROPE_BASE ** (jnp.arange(0, QK_ROPE, 2, dtype=jnp.float32) / QK_ROPE))
    ang = positions.astype(jnp.float32)[..., None] * inv_freq
    return jnp.cos(ang)[:, :, None, :], jnp.sin(ang)[:, :, None, :]


def rope_tail(x, cos, sin):
    x_nope, x_rope = jnp.split(x, [QK_NOPE], axis=-1)
    x1, x2 = jnp.split(x_rope, 2, axis=-1)
    cos = cos.astype(x.dtype)
    sin = sin.astype(x.dtype)
    return jnp.concatenate([x_nope, x1 * cos - x2 * sin, x2 * cos + x1 * sin], axis=-1)


def spatial_gating(zu, zv, norm_g, w_s, b_s):
    B, S, _ = zu.shape
    n = S // CHUNK
    u = jax.nn.gelu(zu)
    v = layer_norm(jax.nn.gelu(zv), norm_g)
    v = v.reshape(B, n, CHUNK, SGU_GROUPS, SGU_GROUP_DIM)
    w_causal = w_s * jnp.tril(jnp.ones((CHUNK, CHUNK), w_s.dtype))
    s = jnp.einsum('gts,bnsgd->bntgd', w_causal, v) + b_s.T[None, None, :, :, None]
    return u * s.reshape(B, S, SGU_WIDTH)


def causal_block_attention(q, k, v):
    B, S, H, Dq = q.shape
    nb = S // Q_BLOCK
    scale = Dq ** -0.5
    qb = q.reshape(B, nb, Q_BLOCK, H, Dq).transpose(1, 0, 3, 2, 4)
    kf = k.astype(jnp.float32)
    k_pos = jnp.arange(S)
    neg = jnp.finfo(jnp.float32).min

    def one_block(args):
        q_blk, blk = args
        s = jnp.einsum('bhqd,bkhd->bhqk', q_blk.astype(jnp.float32), kf) * scale
        q_pos = blk * Q_BLOCK + jnp.arange(Q_BLOCK)
        s = jnp.where(k_pos[None, :] <= q_pos[:, None], s, neg)
        p = jax.nn.softmax(s, axis=-1)
        return jnp.einsum('bhqk,bkhd->bqhd', p.astype(v.dtype), v)

    o = lax.map(one_block, (qb, jnp.arange(nb)))
    return o.transpose(1, 0, 2, 3, 4).reshape(B, S, H, V_HEAD)


def latent_attention(cq, ckv, k_rope, cos, sin, q_lat_norm, kv_lat_norm, w_uq, w_ukv, q_norm, k_norm):
    B, S, _ = cq.shape
    q = (rms_norm(cq, q_lat_norm) @ w_uq).reshape(B, S, MLA_HEADS, QK_HEAD)
    kv = (rms_norm(ckv, kv_lat_norm) @ w_ukv).reshape(B, S, MLA_HEADS, QK_NOPE + V_HEAD)
    k_nope, v = jnp.split(kv, [QK_NOPE], axis=-1)
    k_r = jnp.broadcast_to(k_rope[:, :, None, :], (B, S, MLA_HEADS, QK_ROPE))
    k = jnp.concatenate([k_nope, k_r], axis=-1)
    q = rope_tail(rms_norm(q, q_norm), cos, sin)
    k = rope_tail(rms_norm(k, k_norm), cos, sin)
    o = causal_block_attention(q, k, v)
    return o.reshape(B, S, MLA_WIDTH)


def hybrid_mixer(h, cos, sin, w_in, sgu_norm, sgu_w, sgu_b, q_lat_norm, kv_lat_norm,
                 w_uq, w_ukv, q_norm, k_norm, w_out):
    proj = h @ w_in
    zu, zv, cq, ckv, k_rope = jnp.split(proj, IN_SPLITS, axis=-1)
    a = spatial_gating(zu, zv, sgu_norm, sgu_w, sgu_b)
    m = latent_attention(cq, ckv, k_rope, cos, sin, q_lat_norm, kv_lat_norm,
                         w_uq, w_ukv, q_norm, k_norm)
    return jnp.concatenate([a, m], axis=-1) @ w_out


def swiglu(x, w1, w3, w2):
    return (jax.nn.silu(x @ w1) * (x @ w3)) @ w2


def moe_swiglu(h, router_w, w1, w3, w2):
    B, S, D = h.shape
    xt = h.reshape(-1, D)
    logits = (xt @ router_w).astype(jnp.float32)
    top_val, top_idx = lax.top_k(logits, TOP_K)
    top_w = jax.nn.softmax(top_val, axis=-1)
    gates = jnp.sum(jax.nn.one_hot(top_idx, N_EXPERTS, dtype=jnp.float32) * top_w[..., None],
                    axis=1).astype(h.dtype)
    y = jnp.zeros_like(xt)
    for e in range(N_EXPERTS):
        y = y + gates[:, e:e + 1] * swiglu(xt, w1[e], w3[e], w2[e])
    return y.reshape(B, S, D)


def setup_inputs(seed: int = 0) -> dict:
    key = jax.random.key(seed)
    ks = jax.random.split(key, 32)
    L = DEPTH
    f = jnp.float32

    def nrm(k, shape, scale):
        return jax.random.normal(k, shape, f) * scale

    def gain(k, shape):
        return 1.0 + 0.02 * jax.random.normal(k, shape, f)

    positions = (jnp.arange(SEQ, dtype=jnp.int32)[None, :]
                 + jax.random.randint(ks[2], (BATCH, 1), 0, 1024, dtype=jnp.int32))
    return {
        "x": nrm(ks[0], (BATCH, SEQ, D_MODEL), 1.0),
        "c": nrm(ks[1], (BATCH, D_MODEL), 1.0),
        "positions": positions,
        "ada_w": nrm(ks[3], (L, D_MODEL, N_MOD * D_MODEL), 0.5 * D_MODEL ** -0.5),
        "ada_b": nrm(ks[4], (L, N_MOD * D_MODEL), 0.01),
        "norm_mix": gain(ks[5], (L, D_MODEL)),
        "norm_ffn": gain(ks[6], (L, D_MODEL)),
        "w_in": nrm(ks[7], (L, D_MODEL, D_IN), D_MODEL ** -0.5),
        "sgu_norm": gain(ks[8], (L, SGU_WIDTH)),
        "sgu_w": nrm(ks[9], (L, SGU_GROUPS, CHUNK, CHUNK), CHUNK ** -0.5),
        "sgu_b": 1.0 + 0.1 * jax.random.normal(ks[10], (L, SGU_GROUPS, CHUNK), f),
        "q_lat_norm": gain(ks[11], (L, Q_LORA)),
        "kv_lat_norm": gain(ks[12], (L, KV_LORA)),
        "w_uq": nrm(ks[13], (L, Q_LORA, MLA_HEADS * QK_HEAD), Q_LORA ** -0.5),
        "w_ukv": nrm(ks[14], (L, KV_LORA, MLA_HEADS * (QK_NOPE + V_HEAD)), KV_LORA ** -0.5),
        "q_norm": gain(ks[15], (L, QK_HEAD)),
        "k_norm": gain(ks[16], (L, QK_HEAD)),
        "w_out": nrm(ks[17], (L, D_MIX, D_MODEL), D_MIX ** -0.5),
        "ffn_w1": nrm(ks[18], (N_DENSE_LAYERS, D_MODEL, D_FF), D_MODEL ** -0.5),
        "ffn_w3": nrm(ks[19], (N_DENSE_LAYERS, D_MODEL, D_FF), D_MODEL ** -0.5),
        "ffn_w2": nrm(ks[20], (N_DENSE_LAYERS, D_FF, D_MODEL), D_FF ** -0.5),
        "router_w": nrm(ks[21], (N_MOE_LAYERS, D_MODEL, N_EXPERTS), D_MODEL ** -0.5),
        "moe_w1": nrm(ks[22], (N_MOE_LAYERS, N_EXPERTS, D_MODEL, D_FF_EXPERT), D_MODEL ** -0.5),
        "moe_w3": nrm(ks[23], (N_MOE_LAYERS, N_EXPERTS, D_MODEL, D_FF_EXPERT), D_MODEL ** -0.5),
        "moe_w2": nrm(ks[24], (N_MOE_LAYERS, N_EXPERTS, D_FF_EXPERT, D_MODEL), D_FF_EXPERT ** -0.5),
    }


def reference(x, c, positions, ada_w, ada_b, norm_mix, norm_ffn, w_in, sgu_norm, sgu_w, sgu_b,
              q_lat_norm, kv_lat_norm, w_uq, w_ukv, q_norm, k_norm, w_out,
              ffn_w1, ffn_w3, ffn_w2, router_w, moe_w1, moe_w3, moe_w2):
    cos, sin = rope_tables(positions)
    c_act = jax.nn.silu(c)
    for layer in range(DEPTH):
        mod = c_act @ ada_w[layer] + ada_b[layer]
        sh1, sc1, g1, sh2, sc2, g2 = jnp.split(mod, N_MOD, axis=-1)
        h = modulate(rms_norm(x, norm_mix[layer]), sh1, sc1)
        y = hybrid_mixer(h, cos, sin, w_in[layer], sgu_norm[layer], sgu_w[layer], sgu_b[layer],
                         q_lat_norm[layer], kv_lat_norm[layer], w_uq[layer], w_ukv[layer],
                         q_norm[layer], k_norm[layer], w_out[layer])
        x = x + g1[:, None, :] * y
        h = modulate(rms_norm(x, norm_ffn[layer]), sh2, sc2)
        i = layer // 2
        if layer % 2 == 0:
            y = swiglu(h, ffn_w1[i], ffn_w3[i], ffn_w2[i])
        else:
            y = moe_swiglu(h, router_w[i], moe_w1[i], moe_w3[i], moe_w2[i])
        x = x + g2[:, None, :] * y
    return x
```

```cpp
#include <hip/hip_runtime.h>
#include <cstdio>
#include <cstdint>

#define REPEAT_MASK 0x0u
#ifndef MK_N_LAUNCHES
#define MK_N_LAUNCHES 1
#endif

#define GAS __attribute__((address_space(1)))
#define LAS __attribute__((address_space(3)))
typedef unsigned short bf16_t;
typedef short bf16x8 __attribute__((ext_vector_type(8)));
typedef short s16x4 __attribute__((ext_vector_type(4)));
typedef float f32x4 __attribute__((ext_vector_type(4)));
typedef float f32x2 __attribute__((ext_vector_type(2)));
typedef float f32x16 __attribute__((ext_vector_type(16)));
typedef unsigned u32x4 __attribute__((ext_vector_type(4)));
typedef unsigned u32x2 __attribute__((ext_vector_type(2)));
typedef int i32x4 __attribute__((ext_vector_type(4)));
typedef GAS unsigned gu32;
#define RLX_AGENT __ATOMIC_RELAXED, __HIP_MEMORY_SCOPE_AGENT
#define LDS_WAIT() asm volatile("s_waitcnt lgkmcnt(0)" ::: "memory")
#define VM_WAIT() asm volatile("s_waitcnt vmcnt(0)" ::: "memory")

constexpr int DM = 1024, NB = 8, SEQ = 4096, NTOK = NB * SEQ;
constexpr int SGU_W = 512, NGRP = 8, GDIM = 64, CHUNK = 128;
constexpr int NH = 4, QKN = 128, QKR = 64, QKH = 192, VH = 128;
constexpr int QLORA = 256, KVLORA = 128, D_IN = 1472, D_INP = 1536;
constexpr int DFF = 2816, NEXP = 8, NMOD = 6;
constexpr float EPS = 1e-6f;
constexpr int NWAVES = 8, NTHR = 512;
constexpr int MAXTILES = 135;
constexpr int SLOTROWS = MAXTILES * 256;

constexpr size_t MiB = 1u << 20;
constexpr size_t WS_CTL = 0, CTL_ZERO_BYTES = 1 * MiB;
constexpr size_t WS_MOD = 1 * MiB;
constexpr size_t WS_COS = 2 * MiB, WS_SIN = 6 * MiB;
constexpr size_t WS_RTE = 10 * MiB;
constexpr size_t WS_RTW = WS_RTE + 128 * 1024;
constexpr size_t WS_CNT = WS_RTW + 256 * 1024;
constexpr size_t WS_RMAP = WS_CNT + 16 * 1024;
constexpr size_t WS_RGATE = WS_RMAP + 288 * 1024;
constexpr size_t WS_TAB = WS_RGATE + 288 * 1024;
static_assert(2 * SLOTROWS * 4 <= 288 * 1024 && WS_TAB + 4096 <= 11 * MiB, "route tables");
constexpr size_t WS_SB = 11 * MiB;
constexpr size_t WS_SBIN = 11 * MiB + 224 * 1024;
constexpr size_t WS_RSA = 11 * MiB + 384 * 1024;
constexpr size_t WS_SA = 11 * MiB + 256 * 1024;
constexpr size_t CTL_AMAX = 256 * 1024;
static_assert(WS_RSA + 2 * SLOTROWS * 4 <= 12 * MiB && WS_SB + 9 * 5632 * 4 <= WS_SBIN && WS_SBIN + 2 * 1536 * 4 <= WS_SA && WS_SA + NTOK * 4 <= 12 * MiB && CTL_AMAX + 18 * 2816 * 4 <= CTL_ZERO_BYTES, "int8 tables");
constexpr size_t WS_WIN = 12 * MiB;
constexpr size_t WS_WUQ = 18 * MiB;
constexpr size_t WS_WUKV = 19 * MiB;
constexpr size_t WS_SGUW = 19 * MiB + 512 * 1024;
constexpr size_t WS_WOUT = 20 * MiB;
constexpr size_t WS_WFU = 24 * MiB;
constexpr size_t WS_WFD = 35 * MiB;
constexpr size_t WS_WMU = 41 * MiB;
constexpr size_t WS_WMD = 85 * MiB;
constexpr size_t WS_XB = 129 * MiB;
constexpr size_t WS_H = 193 * MiB;
constexpr size_t WS_BIG = 257 * MiB;
constexpr size_t WS_ACT = WS_BIG;
constexpr size_t WS_U = WS_BIG, WS_GV = WS_BIG + 32 * MiB, WS_CQ = WS_BIG + 64 * MiB, WS_CKV = WS_BIG + 80 * MiB, WS_KR = WS_BIG + 88 * MiB;
constexpr size_t WS_Q = WS_BIG + 92 * MiB, WS_K = WS_BIG + 140 * MiB, WS_V = WS_BIG + 188 * MiB, WS_END = WS_BIG + 220 * MiB;
static_assert(WS_ACT + (size_t)SLOTROWS * DFF * 2 <= WS_END && WS_END <= 512 * MiB, "d_ws map");
static_assert(WS_WMU + (size_t)8 * 5632 * 1024 <= WS_WMD && WS_WMD + (size_t)8 * 1024 * 2816 * 2 <= WS_XB && WS_XB + (size_t)NTOK * DM * 2 <= WS_H && WS_H + (size_t)NTOK * DM * 2 <= WS_BIG, "weights map");
constexpr int CW_BAR = 4096;

constexpr int RING_BYTES = 131072;
constexpr int LDS_TAB_OFF = 139264;
constexpr int LDS_UL_OFF = LDS_TAB_OFF, LDS_IDX_OFF = LDS_TAB_OFF + 512;
constexpr int LDS_BYTES = 163840;
constexpr int MISC_OFF = LDS_BYTES - 256;
static_assert(LDS_IDX_OFF + 12 * 1024 <= MISC_OFF, "LDS tables");
static_assert(LDS_BYTES <= 163840, "LDS");

__device__ __forceinline__ unsigned f2bf(float f) { unsigned u = __builtin_bit_cast(unsigned, f); return (u + 0x7fffu + ((u >> 16) & 1u)) >> 16; }
typedef __bf16 bf16x2_t __attribute__((ext_vector_type(2)));
__device__ __forceinline__ unsigned pk2(float lo, float hi) { const f32x2 v = {lo, hi}; const bf16x2_t b = __builtin_convertvector(v, bf16x2_t); return __builtin_bit_cast(unsigned, b); }
__device__ __forceinline__ float bflo(unsigned w) { return __builtin_bit_cast(float, w << 16); }
__device__ __forceinline__ float bfhi(unsigned w) { return __builtin_bit_cast(float, w & 0xffff0000u); }
__device__ __forceinline__ float bf1(bf16_t h) { return __builtin_bit_cast(float, ((unsigned)h) << 16); }
__device__ __forceinline__ int crow(int r, int hi) { return (r & 3) + 8 * (r >> 2) + 4 * hi; }
__device__ __forceinline__ int lane_id() { int l; asm volatile("v_mbcnt_lo_u32_b32 %0, -1, 0\n\tv_mbcnt_hi_u32_b32 %0, -1, %0" : "=v"(l)); return l; }
__device__ __forceinline__ float wave_sum(float v, int lane) {
#pragma unroll
    for (int o = 1; o < 64; o <<= 1) v += __builtin_bit_cast(float, __builtin_amdgcn_ds_bpermute((lane ^ o) << 2, __builtin_bit_cast(int, v)));
    return v;
}
__device__ __forceinline__ float wave_max(float v, int lane) {
#pragma unroll
    for (int o = 1; o < 64; o <<= 1) v = fmaxf(v, __builtin_bit_cast(float, __builtin_amdgcn_ds_bpermute((lane ^ o) << 2, __builtin_bit_cast(int, v))));
    return v;
}
__device__ __forceinline__ unsigned pack_i8x4(float a, float b, float c, float d) {
    const int ia = (int)__builtin_rintf(a), ib = (int)__builtin_rintf(b), ic = (int)__builtin_rintf(c), id = (int)__builtin_rintf(d);
    return (unsigned)(ia & 255) | ((unsigned)(ib & 255) << 8) | ((unsigned)(ic & 255) << 16) | ((unsigned)id << 24);
}
__device__ __forceinline__ float half_sum(float v) {
    auto rr = __builtin_amdgcn_permlane32_swap(__builtin_bit_cast(unsigned, v), __builtin_bit_cast(unsigned, v), false, false);
    return __builtin_bit_cast(float, (unsigned)rr[0]) + __builtin_bit_cast(float, (unsigned)rr[1]);
}
__device__ __forceinline__ float half_max(float v) {
    auto rr = __builtin_amdgcn_permlane32_swap(__builtin_bit_cast(unsigned, v), __builtin_bit_cast(unsigned, v), false, false);
    return fmaxf(__builtin_bit_cast(float, (unsigned)rr[0]), __builtin_bit_cast(float, (unsigned)rr[1]));
}
__device__ __forceinline__ unsigned ld_agent(const unsigned* p) { return __hip_atomic_load(p, RLX_AGENT); }
__device__ __forceinline__ s16x4 vtr(const LAS unsigned char* p) { typedef short v4i16_t __attribute__((ext_vector_type(4))); return __builtin_bit_cast(s16x4, __builtin_amdgcn_ds_read_tr16_b64_v4i16((LAS v4i16_t*)p)); }

namespace pg8 {
constexpr int BM = 256, BK = 64, HALF = 128, HTB = HALF * BK * 2, STAGE_BYTES = 8 * HTB, NXCD = 8, WGM = 4;
__host__ __device__ __forceinline__ int lds_byte(int r, int c) { const int st = (r >> 4) * 2 + (c >> 5), rr = r & 15, cc = c & 31, ob = rr * 64 + cc * 2; return st * 1024 + (ob ^ (((ob >> 9) & 1) << 5)); }
__host__ __device__ __forceinline__ void stage_rc(int b, int& R, int& C) { const int st = b / 1024, sb = b % 1024, swz = sb ^ (((sb >> 9) & 1) << 5); R = (st >> 1) * 16 + swz / 64; C = (st & 1) * 32 + (swz % 64) / 2; }
__host__ __device__ __forceinline__ int perm32(int rho) { const int n = rho >> 4, i = rho & 15; return 8 * (i >> 2) + 4 * n + (i & 3); }

struct Unit { int pm, pn; const char* a; const char* b; int aux; };

struct StaticOrder {
    int nM, nN, nwg, G, c;
    __device__ void init(int nM_, int nN_, int G_, int c_) { nM = nM_; nN = nN_; nwg = nM * nN; G = G_; c = c_; }
    __device__ bool tile(int i, int& pm, int& pn) const {
        const long L = (long)i * G + c; if (L >= nwg) return false;
        int wgid = (int)L; { const int q = nwg / NXCD, r = nwg % NXCD, xcd = wgid % NXCD, off = wgid / NXCD; wgid = (xcd < r ? xcd * (q + 1) : r * (q + 1) + (xcd - r) * q) + off; }
        const int nig = WGM * nN, gid = wgid / nig, fm = gid * WGM, gsz = (nM - fm) < WGM ? (nM - fm) : WGM;
        pm = fm + ((wgid % nig) % gsz); pn = (wgid % nig) / gsz; return true;
    }
};
struct DenseSched {
    static constexpr bool GATHER = false;
    StaticOrder so; const char* A; const char* Bt; size_t tstep;
    __device__ bool next(int i, Unit& u) const { if (!so.tile(i, u.pm, u.pn)) return false; u.aux = 0; u.a = A + (size_t)u.pm * tstep; u.b = Bt + (size_t)u.pn * tstep; return true; }
    __device__ __forceinline__ void rows(int, const int (&R)[2], const int (&C)[2], int K, unsigned (&v)[2][2]) const {
#pragma unroll
        for (int h = 0; h < 2; ++h)
#pragma unroll
            for (int i = 0; i < 2; ++i) v[h][i] = (unsigned)((h * HALF + R[i]) * K + C[i]) * 2u;
    }
};
template <bool GATHER_> struct MoeSched {
    static constexpr bool GATHER = GATHER_;
    const LAS int* ul; const LAS int* idx; int n, aux0; const char* A; const char* Bt; size_t tstepA, tstepB, estride;
    __device__ bool next(int i, Unit& u) const { if (i >= n) return false; u.pm = ul[4 * i]; u.pn = ul[4 * i + 1]; const int e = ul[4 * i + 2]; u.aux = ul[4 * i + 3] | (e << 8);
        const size_t ko = (size_t)ul[4 * i + 3] * 512;
        u.a = GATHER ? A : A + (size_t)u.pm * tstepA + ko; u.b = Bt + (size_t)e * estride + (size_t)u.pn * tstepB + ko; return true; }
    __device__ __forceinline__ void rows(int ui, const int (&R)[2], const int (&C)[2], int K, unsigned (&v)[2][2]) const {
#pragma unroll
        for (int h = 0; h < 2; ++h)
#pragma unroll
            for (int i = 0; i < 2; ++i) { const int row = GATHER ? idx[ui * 256 + h * HALF + R[i]] : (h * HALF + R[i]); v[h][i] = (unsigned)(row * K + C[i]) * 2u; }
    }
};

template <class Epi, class Sched, bool ALIGN_EPI, bool I8 = false>
__device__ __forceinline__ void gemm_phase(LAS unsigned char* lds, const int wave, const int K, const int ldk, const Sched& S, const Epi& E) {
    int lane = lane_id(); asm volatile("" : "+v"(lane));
    const int wid = wave, tid = wave * 64 + lane, wr = wid >> 2, wc = wid & 3, fr = lane & 15, fq = lane >> 4;
    const int nt = K / BK;
    int Rr[2], Cc[2]; unsigned voffB[2];
#pragma unroll
    for (int i = 0; i < 2; ++i) { stage_rc(tid * 16 + i * 8192, Rr[i], Cc[i]); const int Rb = Epi::PERM ? ((Rr[i] & ~31) + perm32(Rr[i] & 31)) : Rr[i]; voffB[i] = (unsigned)(Rb * ldk + Cc[i]) * 2u; }
    const size_t kstep = (size_t)(BK * 2);
    const size_t hstep = (size_t)HALF * ldk * 2;
    const unsigned ldsw = (unsigned)wid * 1024u;
    const int aoff = lds_byte(wr * 64 + fr, fq * 8), boff = lds_byte(wc * 32 + fr, fq * 8);
#define PG8_SA(b, h) (((b) * 2 + (h)) * HTB)
#define PG8_SB(b, h) ((4 + (b) * 2 + (h)) * HTB)
#define PG8_STAGE_B(bufoff, gbase) do { _Pragma("unroll") for (int _i = 0; _i < 2; ++_i) \
        __builtin_amdgcn_global_load_lds((const unsigned*)((const char*)(gbase) + voffB[_i]), (LAS unsigned*)(lds + (bufoff) + ldsw + _i * 8192), 16, 0, 0); } while (0)
#define PG8_STAGE_A(bufoff, gbase, V, h) do { _Pragma("unroll") for (int _i = 0; _i < 2; ++_i) \
        __builtin_amdgcn_global_load_lds((const unsigned*)((const char*)(gbase) + (V)[h][_i]), (LAS unsigned*)(lds + (bufoff) + ldsw + _i * 8192), 16, 0, 0); } while (0)
#define PG8_LDA(dst, b, h) do { _Pragma("unroll") for (int m = 0; m < 4; ++m) _Pragma("unroll") for (int k = 0; k < 2; ++k) dst[m][k] = *(const LAS bf16x8*)(lds + PG8_SA(b, h) + aoff + m * 2048 + k * 1024); } while (0)
#define PG8_LDB(dst, b, h) do { _Pragma("unroll") for (int n = 0; n < 2; ++n) _Pragma("unroll") for (int k = 0; k < 2; ++k) dst[n][k] = *(const LAS bf16x8*)(lds + PG8_SB(b, h) + boff + n * 2048 + k * 1024); } while (0)
#define PG8_MMA(ai, bj, At, Bt) do { __builtin_amdgcn_s_setprio(1); _Pragma("unroll") for (int m = 0; m < 4; ++m) _Pragma("unroll") for (int n = 0; n < 2; ++n) _Pragma("unroll") for (int k = 0; k < 2; ++k) { \
        if constexpr (I8) acc[ai][bj][m][n] = __builtin_bit_cast(f32x4, __builtin_amdgcn_mfma_i32_16x16x64_i8(__builtin_bit_cast(i32x4, Bt[n][k]), __builtin_bit_cast(i32x4, At[m][k]), __builtin_bit_cast(i32x4, acc[ai][bj][m][n]), 0, 0, 0)); \
        else acc[ai][bj][m][n] = __builtin_amdgcn_mfma_f32_16x16x32_bf16(Bt[n][k], At[m][k], acc[ai][bj][m][n], 0, 0, 0); } __builtin_amdgcn_s_setprio(0); } while (0)
#define PG8_WAIT_V(n) asm volatile("s_waitcnt vmcnt(" #n ")" ::: "memory")
#define PG8_WAIT_L(n) asm volatile("s_waitcnt lgkmcnt(" #n ")" ::: "memory")
#define PG8_BAR __builtin_amdgcn_s_barrier()
#define PG8_SCHED __builtin_amdgcn_sched_barrier(0)
    Unit cur, nxt; int ui = 0;
    if (!S.next(0, cur)) return;
    unsigned vA[2][2], vN[2][2];
    S.rows(0, Rr, Cc, ldk, vA);
#pragma unroll
    for (int h = 0; h < 2; ++h)
#pragma unroll
        for (int i = 0; i < 2; ++i) vN[h][i] = vA[h][i];
    f32x4 acc[2][2][4][2];
#pragma unroll
    for (int a = 0; a < 2; ++a)
#pragma unroll
        for (int b = 0; b < 2; ++b)
#pragma unroll
            for (int m = 0; m < 4; ++m)
#pragma unroll
                for (int n = 0; n < 2; ++n) acc[a][b][m][n] = (f32x4){0.f, 0.f, 0.f, 0.f};
    bf16x8 At[4][2], B0[2][2], B1[2][2];
    const char* cA = cur.a; const char* cB = cur.b;
    PG8_STAGE_B(PG8_SB(0, 0), cB); PG8_STAGE_B(PG8_SB(0, 1), cB + hstep); PG8_STAGE_A(PG8_SA(0, 0), cA, vA, 0); PG8_STAGE_A(PG8_SA(0, 1), cA, vA, 1);
    if (wr == 1) PG8_BAR;
    PG8_WAIT_V(2); PG8_BAR;
    PG8_STAGE_B(PG8_SB(1, 0), cB + kstep); PG8_STAGE_A(PG8_SA(1, 0), cA + kstep, vA, 0); PG8_STAGE_B(PG8_SB(1, 1), cB + hstep + kstep);
    PG8_WAIT_V(6); PG8_BAR;
    for (;;) {
        const bool has_next = S.next(ui + 1, nxt);
        const char* nA = has_next ? nxt.a : cA; const char* nB = has_next ? nxt.b : cB;
        for (int t = 0; t < nt; t += 2) {
            const bool last = (t == nt - 2);
            const char* a1 = cA + (size_t)(t + 1) * kstep;
            const char* a2 = last ? nA : cA + (size_t)(t + 2) * kstep; const char* b2 = last ? nB : cB + (size_t)(t + 2) * kstep;
            const char* a3 = a2 + kstep; const char* b3 = b2 + kstep;
            unsigned v2[2][2];
            if constexpr (Sched::GATHER) {
                if (last && has_next) S.rows(ui + 1, Rr, Cc, ldk, vN);
#pragma unroll
                for (int h = 0; h < 2; ++h)
#pragma unroll
                    for (int i = 0; i < 2; ++i) v2[h][i] = last ? vN[h][i] : vA[h][i];
            } else {
#pragma unroll
                for (int h = 0; h < 2; ++h)
#pragma unroll
                    for (int i = 0; i < 2; ++i) v2[h][i] = vA[h][i];
            }
            PG8_LDB(B0, 0, 0); PG8_LDB(B1, 0, 1); PG8_SCHED; PG8_LDA(At, 0, 0); PG8_STAGE_A(PG8_SA(1, 1), a1, vA, 1);
            PG8_WAIT_V(8); PG8_WAIT_L(0); PG8_BAR; PG8_MMA(0, 0, At, B0); PG8_MMA(0, 1, At, B1); PG8_BAR; PG8_SCHED;
            PG8_LDA(At, 0, 1); PG8_STAGE_B(PG8_SB(0, 0), b2); PG8_STAGE_B(PG8_SB(0, 1), b2 + hstep); PG8_STAGE_A(PG8_SA(0, 0), a2, v2, 0);
            PG8_WAIT_V(8); PG8_WAIT_L(0); PG8_BAR; PG8_MMA(1, 0, At, B0); PG8_MMA(1, 1, At, B1); PG8_BAR; PG8_SCHED;
            PG8_LDB(B0, 1, 0); PG8_LDB(B1, 1, 1); PG8_SCHED; PG8_LDA(At, 1, 0); PG8_STAGE_A(PG8_SA(0, 1), a2, v2, 1);
            PG8_WAIT_V(8); PG8_WAIT_L(0); PG8_BAR; PG8_MMA(0, 0, At, B0); PG8_MMA(0, 1, At, B1); PG8_BAR; PG8_SCHED;
            PG8_LDA(At, 1, 1); PG8_STAGE_B(PG8_SB(1, 0), b3); PG8_STAGE_B(PG8_SB(1, 1), b3 + hstep); PG8_STAGE_A(PG8_SA(1, 0), a3, v2, 0);
            PG8_WAIT_V(8); PG8_WAIT_L(0); PG8_BAR; PG8_MMA(1, 0, At, B0); PG8_MMA(1, 1, At, B1); PG8_BAR; PG8_SCHED;
        }
        if constexpr (ALIGN_EPI) { if (wr == 0) PG8_BAR; }
        E(acc, cur, wr, wc, fr, fq);
        if (!has_next) break;
#pragma unroll
        for (int a = 0; a < 2; ++a)
#pragma unroll
            for (int b = 0; b < 2; ++b)
#pragma unroll
                for (int m = 0; m < 4; ++m)
#pragma unroll
                    for (int n = 0; n < 2; ++n) acc[a][b][m][n] = (f32x4){0.f, 0.f, 0.f, 0.f};
        cur = nxt; cA = nA; cB = nB; ++ui;
#pragma unroll
        for (int h = 0; h < 2; ++h)
#pragma unroll
            for (int i = 0; i < 2; ++i) vA[h][i] = vN[h][i];
        if constexpr (ALIGN_EPI) { if (wr == 1) PG8_BAR; }
    }
    PG8_WAIT_V(0);
    if constexpr (!ALIGN_EPI) { if (wr == 0) PG8_BAR; }
    PG8_BAR;
#undef PG8_SA
#undef PG8_SB
#undef PG8_STAGE_A
#undef PG8_STAGE_B
#undef PG8_LDA
#undef PG8_LDB
#undef PG8_MMA
#undef PG8_WAIT_V
#undef PG8_WAIT_L
#undef PG8_BAR
#undef PG8_SCHED
}
}

__device__ __forceinline__ float gelu_tanh(float x) {
    const float t = x * (1.0f + 0.044715f * x * x) * 2.3022082f;
    return x * __builtin_amdgcn_rcpf(1.0f + __builtin_amdgcn_exp2f(-t));
}
__device__ __forceinline__ float silu_f(float x) { return x * __builtin_amdgcn_rcpf(1.0f + __builtin_amdgcn_exp2f(-1.4426950408889634f * x)); }

struct EpiInProj {
    static constexpr bool PERM = true;
    bf16_t *U, *GV, *CQ, *CKV, *KR; const float* sa; const float* sb;
    template <int KIND> __device__ __forceinline__ void body(const f32x4 (&acc)[2][2][4][2], int pn, int row0, const float (&srow)[8], int wc, int fq) const {
#pragma unroll
        for (int bj = 0; bj < 2; ++bj) {
            if (KIND == 3 && bj == 1 && wc >= 2) continue;
            const float* sbp = sb + pn * 256 + bj * 128 + wc * 32 + 8 * fq; const f32x4 sc0 = *(const f32x4*)sbp, sc1 = *(const f32x4*)(sbp + 4);
#pragma unroll
            for (int ai = 0; ai < 2; ++ai)
#pragma unroll
                for (int m = 0; m < 4; ++m) {
                    const int row = row0 + ai * 128 + m * 16; const int blk = row >> 5, tok = row & 31; const float sr = srow[ai * 4 + m];
                    const i32x4 i0 = __builtin_bit_cast(i32x4, acc[ai][bj][m][0]), i1 = __builtin_bit_cast(i32x4, acc[ai][bj][m][1]); float v[8];
#pragma unroll
                    for (int j = 0; j < 4; ++j) { v[j] = (float)i0[j] * (sr * sc0[j]); v[4 + j] = (float)i1[j] * (sr * sc1[j]); }
                    if constexpr (KIND < 2) {
                        float t[8];
#pragma unroll
                        for (int j = 0; j < 8; ++j) t[j] = v[j] * v[j];
#pragma unroll
                        for (int j = 0; j < 8; ++j) t[j] = t[j] * -0.10294324f + -2.3022082f;
#pragma unroll
                        for (int j = 0; j < 8; ++j) t[j] = __builtin_amdgcn_exp2f(t[j] * v[j]);
#pragma unroll
                        for (int j = 0; j < 8; ++j) t[j] = t[j] + 1.0f;
#pragma unroll
                        for (int j = 0; j < 8; ++j) t[j] = __builtin_amdgcn_rcpf(t[j]);
#pragma unroll
                        for (int j = 0; j < 8; ++j) v[j] = v[j] * t[j];
                    }
                    u32x4 w; w.x = pk2(v[0], v[1]); w.y = pk2(v[2], v[3]); w.z = pk2(v[4], v[5]); w.w = pk2(v[6], v[7]);
                    if constexpr (KIND == 0) *(u32x4*)(U + (size_t)row * 512 + pn * 256 + bj * 128 + wc * 32 + 8 * fq) = w;
                    else if constexpr (KIND == 1) *(u32x4*)(GV + (size_t)row * 512 + (pn - 2) * 256 + bj * 128 + wc * 32 + 8 * fq) = w;
                    else if constexpr (KIND == 2) *(u32x4*)(CQ + ((size_t)(blk * 32 + 16 * bj + 4 * wc + fq) * 32 + tok) * 8) = w;
                    else if (bj == 0) *(u32x4*)(CKV + ((size_t)(blk * 16 + 4 * wc + fq) * 32 + tok) * 8) = w;
                    else { u32x2 a; a.x = w.x; a.y = w.y; u32x2 b; b.x = w.z; b.y = w.w; const size_t o = ((size_t)(blk * 16 + 8 * wc + 2 * fq) * 32 + tok) * 4; *(u32x2*)(KR + o) = a; *(u32x2*)(KR + o + 128) = b; }
                }
        }
    }
    __device__ __forceinline__ void operator()(const f32x4 (&acc)[2][2][4][2], const pg8::Unit& u, int wr, int wc, int fr, int fq) const {
        const int row0 = u.pm * 256 + wr * 64 + fr; const int pn = u.pn;
        float srow[8];
#pragma unroll
        for (int q = 0; q < 8; ++q) srow[q] = sa[row0 + (q >> 2) * 128 + (q & 3) * 16];
        asm volatile("" : "+v"(srow[0]), "+v"(srow[1]), "+v"(srow[2]), "+v"(srow[3]), "+v"(srow[4]), "+v"(srow[5]), "+v"(srow[6]), "+v"(srow[7]));
        if (pn < 2) body<0>(acc, pn, row0, srow, wc, fq);
        else if (pn < 4) body<1>(acc, pn, row0, srow, wc, fq);
        else if (pn == 4) body<2>(acc, pn, row0, srow, wc, fq);
        else body<3>(acc, pn, row0, srow, wc, fq);
    }
};
__device__ __forceinline__ u32x4 pack8(const f32x4& a, const f32x4& b) { u32x4 w; w.x = pk2(a[0], a[1]); w.y = pk2(a[2], a[3]); w.z = pk2(b[0], b[1]); w.w = pk2(b[2], b[3]); return w; }
__device__ __forceinline__ f32x4 bf4lo(const u32x4& w) { return (f32x4){bflo(w.x), bfhi(w.x), bflo(w.y), bfhi(w.y)}; }
__device__ __forceinline__ f32x4 bf4hi(const u32x4& w) { return (f32x4){bflo(w.z), bfhi(w.z), bflo(w.w), bfhi(w.w)}; }
template <bool BASE_F32> struct EpiResidB {
    static constexpr bool PERM = true;
    const void* base; bf16_t* out; const float* gate;
    __device__ __forceinline__ void operator()(const f32x4 (&acc)[2][2][4][2], const pg8::Unit& u, int wr, int wc, int fr, int fq) const {
        const int row0 = u.pm * 256 + wr * 64 + fr, col0 = u.pn * 256 + wc * 32 + 8 * fq; const int b = u.pm >> 4;
        f32x4 gv[2][2];
#pragma unroll
        for (int bj = 0; bj < 2; ++bj)
#pragma unroll
            for (int n = 0; n < 2; ++n) gv[bj][n] = *(const f32x4*)(gate + (size_t)b * (NMOD * DM) + col0 + bj * 128 + 4 * n);
        if constexpr (BASE_F32) {
#pragma unroll
            for (int ai = 0; ai < 2; ++ai) {
                f32x4 bs[4][2][2];
#pragma unroll
                for (int m = 0; m < 4; ++m)
#pragma unroll
                    for (int bj = 0; bj < 2; ++bj)
#pragma unroll
                        for (int n = 0; n < 2; ++n) bs[m][bj][n] = *(const f32x4*)((const float*)base + (size_t)(row0 + ai * 128 + m * 16) * DM + col0 + bj * 128 + 4 * n);
#pragma unroll
                for (int m = 0; m < 4; ++m)
#pragma unroll
                    for (int bj = 0; bj < 2; ++bj)
                        *(u32x4*)(out + (size_t)(row0 + ai * 128 + m * 16) * DM + col0 + bj * 128) = pack8(bs[m][bj][0] + gv[bj][0] * acc[ai][bj][m][0], bs[m][bj][1] + gv[bj][1] * acc[ai][bj][m][1]);
                asm volatile("" ::: "memory");
            }
        } else {
            u32x4 bs[2][4][2];
#pragma unroll
            for (int ai = 0; ai < 2; ++ai)
#pragma unroll
                for (int m = 0; m < 4; ++m)
#pragma unroll
                    for (int bj = 0; bj < 2; ++bj) bs[ai][m][bj] = *(const u32x4*)((const bf16_t*)base + (size_t)(row0 + ai * 128 + m * 16) * DM + col0 + bj * 128);
#pragma unroll
            for (int ai = 0; ai < 2; ++ai)
#pragma unroll
                for (int m = 0; m < 4; ++m)
#pragma unroll
                    for (int bj = 0; bj < 2; ++bj)
                        *(u32x4*)(out + (size_t)(row0 + ai * 128 + m * 16) * DM + col0 + bj * 128) = pack8(bf4lo(bs[ai][m][bj]) + gv[bj][0] * acc[ai][bj][m][0], bf4hi(bs[ai][m][bj]) + gv[bj][1] * acc[ai][bj][m][1]);
            asm volatile("" ::: "memory");
        }
    }
};
struct EpiSwiGLU {
    static constexpr bool PERM = true;
    bf16_t* O;
    __device__ __forceinline__ void operator()(const f32x4 (&acc)[2][2][4][2], const pg8::Unit& u, int wr, int wc, int fr, int fq) const {
        const int row0 = u.pm * 256 + wr * 64 + fr, col = u.pn * 128 + wc * 32 + 8 * fq;
#pragma unroll
        for (int ai = 0; ai < 2; ++ai)
#pragma unroll
            for (int m = 0; m < 4; ++m) {
                f32x4 g0 = acc[ai][0][m][0], g1 = acc[ai][0][m][1]; const f32x4 u0 = acc[ai][1][m][0], u1 = acc[ai][1][m][1];
#pragma unroll
                for (int j = 0; j < 4; ++j) { g0[j] = silu_f(g0[j]) * u0[j]; g1[j] = silu_f(g1[j]) * u1[j]; }
                u32x4 w; w.x = pk2(g0[0], g0[1]); w.y = pk2(g0[2], g0[3]); w.z = pk2(g1[0], g1[1]); w.w = pk2(g1[2], g1[3]);
                *(u32x4*)(O + (size_t)(row0 + ai * 128 + m * 16) * DFF + col) = w;
            }
    }
};
struct EpiSwiGLU8 {
    static constexpr bool PERM = true;
    bf16_t* O; const float* sa; const float* sb; const int* rowmap;
    __device__ __forceinline__ void operator()(const f32x4 (&acc)[2][2][4][2], const pg8::Unit& u, int wr, int wc, int fr, int fq) const {
        const int row0 = u.pm * 256 + wr * 64 + fr, col = u.pn * 128 + wc * 32 + 8 * fq;
        const float* sbp = sb + (size_t)(u.aux >> 8) * 5632 + u.pn * 256 + wc * 32 + 8 * fq;
        f32x2 sgl[4], sul[4];
        { const f32x4 a0 = *(const f32x4*)sbp, a1 = *(const f32x4*)(sbp + 4), b0 = *(const f32x4*)(sbp + 128), b1 = *(const f32x4*)(sbp + 132);
          sgl[0] = (f32x2){a0.x, a0.y} * -1.4426950408889634f; sgl[1] = (f32x2){a0.z, a0.w} * -1.4426950408889634f; sgl[2] = (f32x2){a1.x, a1.y} * -1.4426950408889634f; sgl[3] = (f32x2){a1.z, a1.w} * -1.4426950408889634f;
          sul[0] = (f32x2){b0.x, b0.y} * -0.6931471805599453f; sul[1] = (f32x2){b0.z, b0.w} * -0.6931471805599453f; sul[2] = (f32x2){b1.x, b1.y} * -0.6931471805599453f; sul[3] = (f32x2){b1.z, b1.w} * -0.6931471805599453f; }
        float srow[8];
#pragma unroll
        for (int q = 0; q < 8; ++q) srow[q] = sa[row0 + (q >> 2) * 128 + (q & 3) * 16];
        asm volatile("" : "+v"(srow[0]), "+v"(srow[1]), "+v"(srow[2]), "+v"(srow[3]), "+v"(srow[4]), "+v"(srow[5]), "+v"(srow[6]), "+v"(srow[7]));
#pragma unroll
        for (int ai = 0; ai < 2; ++ai)
#pragma unroll
            for (int m = 0; m < 4; ++m) {
                const int row = row0 + ai * 128 + m * 16;
                const float s = srow[ai * 4 + m];
                const i32x4 ig0 = __builtin_bit_cast(i32x4, acc[ai][0][m][0]), ig1 = __builtin_bit_cast(i32x4, acc[ai][0][m][1]), iu0 = __builtin_bit_cast(i32x4, acc[ai][1][m][0]), iu1 = __builtin_bit_cast(i32x4, acc[ai][1][m][1]);
                f32x2 arg[4], up[4], d[4], r[4];
#pragma unroll
                for (int p = 0; p < 4; ++p) {
                    const f32x2 ig = {(float)(p < 2 ? ig0[2 * p] : ig1[2 * p - 4]), (float)(p < 2 ? ig0[2 * p + 1] : ig1[2 * p - 3])};
                    const f32x2 iu = {(float)(p < 2 ? iu0[2 * p] : iu1[2 * p - 4]), (float)(p < 2 ? iu0[2 * p + 1] : iu1[2 * p - 3])};
                    arg[p] = ig * (sgl[p] * s); up[p] = iu * (sul[p] * s); }
#pragma unroll
                for (int p = 0; p < 4; ++p) { d[p].x = __builtin_amdgcn_exp2f(arg[p].x); d[p].y = __builtin_amdgcn_exp2f(arg[p].y); }
#pragma unroll
                for (int p = 0; p < 4; ++p) d[p] = d[p] + 1.0f;
#pragma unroll
                for (int p = 0; p < 4; ++p) { r[p].x = __builtin_amdgcn_rcpf(d[p].x); r[p].y = __builtin_amdgcn_rcpf(d[p].y); }
#pragma unroll
                for (int p = 0; p < 4; ++p) up[p] = up[p] * r[p];
                unsigned wv[4];
#pragma unroll
                for (int p = 0; p < 4; ++p) { const f32x2 o = arg[p] * up[p]; wv[p] = pk2(o.x, o.y); }
                u32x4 w; w.x = wv[0]; w.y = wv[1]; w.z = wv[2]; w.w = wv[3];
                *(u32x4*)(O + (size_t)row * DFF + col) = w;
            }
    }
};
template <bool FINAL> struct EpiMoeDownB {
    static constexpr bool PERM = true;
    bf16_t* xb; float* out; const float* g2; const int* rowmap; const float* rowgate;
    __device__ __forceinline__ void operator()(const f32x4 (&acc)[2][2][4][2], const pg8::Unit& u, int wr, int wc, int fr, int fq) const {
        const int row0 = u.pm * 256 + wr * 64 + fr, col0 = u.pn * 256 + wc * 32 + 8 * fq;
        const int bT = __builtin_amdgcn_readfirstlane(rowmap[u.pm * 256]) >> 12;
        f32x4 gvT[2][2];
#pragma unroll
        for (int bj = 0; bj < 2; ++bj)
#pragma unroll
            for (int n = 0; n < 2; ++n) gvT[bj][n] = *(const f32x4*)(g2 + (size_t)bT * (NMOD * DM) + col0 + bj * 128 + 4 * n);
        int tok[8]; float gt[8];
#pragma unroll
        for (int q = 0; q < 8; ++q) { const int row = row0 + (q >> 2) * 128 + (q & 3) * 16; tok[q] = rowmap[row]; gt[q] = rowgate[row]; }
#pragma unroll
        for (int ai = 0; ai < 2; ++ai) {
            u32x4 bs[4][2];
#pragma unroll
            for (int m = 0; m < 4; ++m) { const int tc = tok[ai * 4 + m] < 0 ? 0 : tok[ai * 4 + m];
#pragma unroll
                for (int bj = 0; bj < 2; ++bj) bs[m][bj] = *(const u32x4*)(xb + (size_t)tc * DM + col0 + bj * 128); }
#pragma unroll
            for (int m = 0; m < 4; ++m) { const int q = ai * 4 + m;
                if (tok[q] >= 0) {
                    f32x4 g[2][2];
#pragma unroll
                    for (int bj = 0; bj < 2; ++bj)
#pragma unroll
                        for (int n = 0; n < 2; ++n) g[bj][n] = gvT[bj][n];
                    const int bb = tok[q] >> 12;
                    if (bb != bT) {
#pragma unroll
                        for (int bj = 0; bj < 2; ++bj)
#pragma unroll
                            for (int n = 0; n < 2; ++n) g[bj][n] = *(const f32x4*)(g2 + (size_t)bb * (NMOD * DM) + col0 + bj * 128 + 4 * n);
                    }
#pragma unroll
                    for (int bj = 0; bj < 2; ++bj) {
                        const f32x4 o0 = bf4lo(bs[m][bj]) + g[bj][0] * gt[q] * acc[ai][bj][m][0], o1 = bf4hi(bs[m][bj]) + g[bj][1] * gt[q] * acc[ai][bj][m][1];
                        if constexpr (FINAL) { float* op = out + (size_t)tok[q] * DM + col0 + bj * 128; *(f32x4*)op = o0; *(f32x4*)(op + 4) = o1; }
                        else *(u32x4*)(xb + (size_t)tok[q] * DM + col0 + bj * 128) = pack8(o0, o1);
                    }
                }
            }
            asm volatile("" ::: "memory");
        }
    }
};

#define XB_TMO      128
#define XB_XCNT(j)  (256  + 64 * (j))
#define XB_XSUB(j)  (1280 + 64 * (j))
#define XB_XGEN(j)  (2304 + 64 * (j))
#define XB_TOP      3328
#define XB_TOPGEN   3392
#define XCD_BAR_WORDS 3456
#define XB_SPIN_CAP (1u << 18)
__device__ __forceinline__ unsigned xb_ld(unsigned* p)              { return __hip_atomic_load(p, __ATOMIC_RELAXED, __HIP_MEMORY_SCOPE_AGENT); }
__device__ __forceinline__ unsigned xb_add(unsigned* p, unsigned v) { return __hip_atomic_fetch_add(p, v, __ATOMIC_RELAXED, __HIP_MEMORY_SCOPE_AGENT); }
__device__ __forceinline__ unsigned xb_xcc_id() { return (unsigned)__builtin_amdgcn_s_getreg((3 << 11) | 20) & 0xFu; }
#define XB_SPIN(cond, bar) do { unsigned _sp = 0; while (cond) { __builtin_amdgcn_s_sleep(1); \
    if ((++_sp & 255u) == 0u) { if (xb_ld(&(bar)[XB_TMO])) break; if (_sp > XB_SPIN_CAP) { atomicAdd(&(bar)[XB_TMO], 1u); break; } } } } while (0)
struct XcdBarrier { unsigned* bar; unsigned x; volatile LAS unsigned* st; int w; };
__device__ __forceinline__ XcdBarrier xcd_barrier_post(unsigned* bar, volatile LAS unsigned* st, int wave) {
    XcdBarrier b; b.bar = bar; b.x = xb_xcc_id(); b.st = st; b.w = wave;
    if (wave == 0 && lane_id() == 0) (void)xb_add(&bar[XB_XCNT(b.x)], 1u);
    return b;
}
__device__ __forceinline__ void xcd_barrier_complete(unsigned* bar, unsigned x, unsigned& nloc, unsigned& nx) {
    const unsigned G = gridDim.x * gridDim.y * gridDim.z;
    unsigned sum, cnt, mine, sp = 0u;
    for (;;) {
        sum = 0u; cnt = 0u; mine = 0u;
#pragma unroll
        for (unsigned j = 0; j < 16; ++j) { const unsigned c = xb_ld(&bar[XB_XCNT(j)]); sum += c; cnt += (c > 0u) ? 1u : 0u; mine = (j == x) ? c : mine; }
        if (sum == G) break;
        __builtin_amdgcn_s_sleep(1);
        if ((++sp & 255u) == 0u) { if (xb_ld(&bar[XB_TMO])) break; if (sp > XB_SPIN_CAP) { atomicAdd(&bar[XB_TMO], 1u); break; } }
    }
    nloc = mine > 0u ? mine : 1u; nx = cnt > 0u ? cnt : 1u;
}
__device__ __forceinline__ void xcd_barrier(const XcdBarrier& b) {
    asm volatile("s_waitcnt vmcnt(0)" ::: "memory");
    __syncthreads();
    if (b.w == 0 && lane_id() == 0) {
        unsigned* bar = b.bar; unsigned bx = b.x;
        asm volatile("" : "+s"(bar), "+s"(bx));
        __builtin_amdgcn_s_waitcnt(0);
        unsigned nloc = b.st[0], nx = b.st[1];
        if (nloc == 0u) { xcd_barrier_complete(bar, bx, nloc, nx); b.st[0] = nloc; b.st[1] = nx; }
        const unsigned old = xb_add(&bar[XB_XSUB(bx)], 1u);
        const unsigned gen = old / nloc;
        if (old + 1u == (gen + 1u) * nloc) {
            __builtin_amdgcn_fence(__ATOMIC_RELEASE, "agent");
            asm volatile("s_waitcnt vmcnt(0)" ::: "memory");
            const unsigned og = xb_add(&bar[XB_TOP], 1u);
            const unsigned tg = og / nx;
            if (og + 1u == (tg + 1u) * nx) xb_add(&bar[XB_TOPGEN], 1u);
            else XB_SPIN(xb_ld(&bar[XB_TOPGEN]) == tg, bar);
            __builtin_amdgcn_fence(__ATOMIC_ACQUIRE, "agent");
            xb_add(&bar[XB_XGEN(bx)], 1u);
            asm volatile("s_waitcnt vmcnt(0)" ::: "memory");
        } else {
            XB_SPIN(xb_ld(&bar[XB_XGEN(bx)]) == gen, bar);
            __builtin_amdgcn_fence(__ATOMIC_ACQUIRE, "agent");
            asm volatile("s_waitcnt vmcnt(0)" ::: "memory");
        }
    }
    __syncthreads();
}

struct Frame {
    LAS unsigned char* lds;
    int tid, lane, wave, vcu, G;
    GAS float* out; GAS unsigned char* ws;
};
__device__ __forceinline__ const GAS void* karg_in(int k) {
    const __attribute__((address_space(4))) char* p = (const __attribute__((address_space(4))) char*)__builtin_amdgcn_kernarg_segment_ptr();
    asm volatile("" : "+s"(p));
    return (const GAS void*)*(const void* const __attribute__((address_space(4)))*)(p + 8 * k);
}
enum { I_X = 0, I_C, I_POS, I_ADAW, I_ADAB, I_NMIX, I_NFFN, I_WIN, I_SGUN, I_SGUW, I_SGUB, I_QLN, I_KVLN, I_WUQ, I_WUKV, I_QN, I_KN, I_WOUT, I_FW1, I_FW3, I_FW2, I_RW, I_MW1, I_MW3, I_MW2 };
#define FIN(T, k) ((const T*)(const GAS T*)karg_in(k))
#define WSP(T, off) ((T*)(GAS T*)(F.ws + (off)))
__device__ __forceinline__ Frame phase_frame(const Frame& F0) {
    Frame F = F0; int t = F0.wave * 64 + lane_id(); asm volatile("" : "+v"(t)); { GAS unsigned char* w = F0.ws; GAS float* o = F0.out; asm volatile("" : "+s"(w), "+s"(o)); F.ws = w; F.out = o; } F.tid = t; F.lane = t & 63; return F;
}

__device__ __forceinline__ void transpose_item(const float* W, int K, int N, int k0, int n0, bf16_t* wt0, const float* kscale, LAS float* scr, int lane) {
    f32x4 v[8]; const int rr = lane >> 3, c4 = (lane & 7) * 4;
#pragma unroll
    for (int i = 0; i < 8; ++i) v[i] = *(const f32x4*)(W + (size_t)(k0 + 8 * i + rr) * N + n0 + c4);
#pragma unroll
    for (int i = 0; i < 8; ++i) { const int kk = 8 * i + rr; f32x4 x = v[i]; if (kscale) x = x * kscale[k0 + kk];
        scr[kk * 33 + c4] = x.x; scr[kk * 33 + c4 + 1] = x.y; scr[kk * 33 + c4 + 2] = x.z; scr[kk * 33 + c4 + 3] = x.w; }
    LDS_WAIT(); asm volatile("" ::: "memory");
    const int c = lane & 7;
#pragma unroll
    for (int j = 0; j < 4; ++j) { const int n = (lane >> 3) + 8 * j; const LAS float* s = scr + (8 * c) * 33 + n;
        u32x4 o; o.x = pk2(s[0 * 33], s[1 * 33]); o.y = pk2(s[2 * 33], s[3 * 33]); o.z = pk2(s[4 * 33], s[5 * 33]); o.w = pk2(s[6 * 33], s[7 * 33]);
        *(u32x4*)(wt0 + (size_t)n * K + k0 + 8 * c) = o; }
    LDS_WAIT(); asm volatile("" ::: "memory");
}
template <int NPITCH, bool ILV>
__device__ __forceinline__ void quant_strip(const float* W, int s, signed char* WQ, float* sb, int nb, LAS unsigned char* lds, int wave, int lane) {
    LAS float* scr = (LAS float*)(lds + wave * 16896); LAS float* cm = (LAS float*)(lds + 8 * 16896);
    const int k0 = 128 * wave, n0 = 32 * nb; const int rr = lane >> 3, c4 = (lane & 7) * 4;
    f32x4 v[16];
#pragma unroll
    for (int i = 0; i < 16; ++i) v[i] = *(const f32x4*)(W + (size_t)(k0 + 8 * i + rr) * NPITCH + n0 + c4);
    float m0 = 0.f, m1 = 0.f, m2 = 0.f, m3 = 0.f;
#pragma unroll
    for (int i = 0; i < 16; ++i) { const int kk = 8 * i + rr; scr[kk * 33 + c4] = v[i].x; scr[kk * 33 + c4 + 1] = v[i].y; scr[kk * 33 + c4 + 2] = v[i].z; scr[kk * 33 + c4 + 3] = v[i].w;
        m0 = fmaxf(m0, fabsf(v[i].x)); m1 = fmaxf(m1, fabsf(v[i].y)); m2 = fmaxf(m2, fabsf(v[i].z)); m3 = fmaxf(m3, fabsf(v[i].w)); }
#pragma unroll
    for (int o = 8; o < 64; o <<= 1) { const int src = (lane ^ o) << 2;
        m0 = fmaxf(m0, __builtin_bit_cast(float, __builtin_amdgcn_ds_bpermute(src, __builtin_bit_cast(int, m0)))); m1 = fmaxf(m1, __builtin_bit_cast(float, __builtin_amdgcn_ds_bpermute(src, __builtin_bit_cast(int, m1))));
        m2 = fmaxf(m2, __builtin_bit_cast(float, __builtin_amdgcn_ds_bpermute(src, __builtin_bit_cast(int, m2)))); m3 = fmaxf(m3, __builtin_bit_cast(float, __builtin_amdgcn_ds_bpermute(src, __builtin_bit_cast(int, m3)))); }
    if (lane < 8) { cm[wave * 32 + c4] = m0; cm[wave * 32 + c4 + 1] = m1; cm[wave * 32 + c4 + 2] = m2; cm[wave * 32 + c4 + 3] = m3; }
    __syncthreads();
    const int n = lane & 31, half = lane >> 5; const int ng = n0 + n, orow = ILV ? 256 * (ng >> 7) + 128 * s + (ng & 127) : ng;
    float am = 0.f;
#pragma unroll
    for (int w = 0; w < 8; ++w) am = fmaxf(am, cm[w * 32 + n]);
    const float inv = am > 0.f ? 127.0f / am : 0.f;
    if (wave == 0 && half == 0) sb[orow] = am * (1.0f / 127.0f);
    const LAS float* sp = scr + (64 * half) * 33 + n;
#pragma unroll
    for (int q = 0; q < 4; ++q) { u32x4 o;
        o.x = pack_i8x4(sp[(16 * q + 0) * 33] * inv, sp[(16 * q + 1) * 33] * inv, sp[(16 * q + 2) * 33] * inv, sp[(16 * q + 3) * 33] * inv);
        o.y = pack_i8x4(sp[(16 * q + 4) * 33] * inv, sp[(16 * q + 5) * 33] * inv, sp[(16 * q + 6) * 33] * inv, sp[(16 * q + 7) * 33] * inv);
        o.z = pack_i8x4(sp[(16 * q + 8) * 33] * inv, sp[(16 * q + 9) * 33] * inv, sp[(16 * q + 10) * 33] * inv, sp[(16 * q + 11) * 33] * inv);
        o.w = pack_i8x4(sp[(16 * q + 12) * 33] * inv, sp[(16 * q + 13) * 33] * inv, sp[(16 * q + 14) * 33] * inv, sp[(16 * q + 15) * 33] * inv);
        *(u32x4*)(WQ + (size_t)orow * DM + k0 + 64 * half + 16 * q) = o; }
    __syncthreads();
}
__device__ __forceinline__ void up_item(const float* W, int s, bf16_t* WT, int r, LAS float* scr, int lane) {
    const int kb = r / 88, nb = r % 88, n0 = 32 * nb; const int orow = 256 * (n0 >> 7) + 128 * s + (n0 & 127);
    transpose_item(W, DM, DFF, 64 * kb, n0, WT + (size_t)orow * DM, nullptr, scr, lane);
}
__device__ __forceinline__ void down_item(const float* W, bf16_t* WT, int r, LAS float* scr, int lane) {
    const int kb = r / 32, nb = r % 32;
    transpose_item(W, DFF, DM, 64 * kb, 32 * nb, WT + (size_t)(32 * nb) * DFF, nullptr, scr, lane);
}
__device__ __forceinline__ void p0_prologue(const Frame& F0) {
    Frame F = phase_frame(F0);
    {
        LAS float* ca = (LAS float*)(F.lds + 69632); LAS float* red = (LAS float*)(F.lds + 102400);
        if ((int)blockIdx.x < 192) {
            for (int i = F.tid; i < NB * DM; i += NTHR) { const float v = FIN(float, I_C)[i]; ca[i] = v / (1.0f + __expf(-v)); }
            __syncthreads();
        }
        for (int it = blockIdx.x; it < 192; it += F.G) {
            const int l = it / 96, j0 = 64 * (it % 96), cg = F.tid & 63, kg = F.tid >> 6;
            const float* W = FIN(float, I_ADAW) + (size_t)l * DM * (NMOD * DM) + j0 + cg;
            float a[NB];
#pragma unroll
            for (int b = 0; b < NB; ++b) a[b] = 0.f;
#pragma unroll 32
            for (int k = 128 * kg; k < 128 * kg + 128; ++k) { const float w = W[(size_t)k * (NMOD * DM)];
#pragma unroll
                for (int b = 0; b < NB; ++b) a[b] += ca[b * DM + k] * w; }
#pragma unroll
            for (int b = 0; b < NB; ++b) red[(kg * 64 + cg) * NB + b] = a[b];
            __syncthreads();
            { const int b = F.tid >> 6; float s = 0.f;
#pragma unroll
              for (int k2 = 0; k2 < 8; ++k2) s += red[(k2 * 64 + cg) * NB + b];
              WSP(float, WS_MOD)[(size_t)(l * NB + b) * (NMOD * DM) + j0 + cg] = s + FIN(float, I_ADAB)[(size_t)l * (NMOD * DM) + j0 + cg]; }
            __syncthreads();
        }
    }
    for (int it = F.vcu; it < 18 * 88; it += F.G) {
        const int mat = it / 88, nb = it % 88, s = mat & 1;
        if (mat < 2) quant_strip<DFF, true>(s ? FIN(float, I_FW3) : FIN(float, I_FW1), s, (signed char*)(F.ws + WS_WFU), WSP(float, WS_SB), nb, F.lds, F.wave, F.lane);
        else { const int e = (mat - 2) >> 1; quant_strip<DFF, true>((s ? FIN(float, I_MW3) : FIN(float, I_MW1)) + (size_t)e * DM * DFF, s, (signed char*)(F.ws + WS_WMU) + (size_t)e * 5632 * DM, WSP(float, WS_SB) + (size_t)(1 + e) * 5632, nb, F.lds, F.wave, F.lane); }
    }
    for (int it = F.vcu; it < 2 * 46; it += F.G) { const int l = it / 46, nb = it % 46;
        quant_strip<D_IN, false>(FIN(float, I_WIN) + (size_t)l * DM * D_IN, 0, (signed char*)(F.ws + WS_WIN) + (size_t)l * D_INP * DM, WSP(float, WS_SBIN) + l * D_INP, nb, F.lds, F.wave, F.lane); }
    LAS float* scr = (LAS float*)(F.lds + F.wave * 8704);
    const int gw = F.vcu * NWAVES + F.wave, NGW = F.G * NWAVES;
    constexpr int GI = 1408, NITEMS = 29 * GI;
    for (int it = gw; it < NITEMS; it += NGW) {
        const int grp = it / GI; int r = it % GI;
        if (grp < 2) { const int l = grp;
            if (r < 736) continue;
            r -= 736;
            if (r < 96) { transpose_item(FIN(float, I_WUQ) + (size_t)l * QLORA * 768, QLORA, 768, 64 * (r / 24), 32 * (r % 24), WSP(bf16_t, WS_WUQ) + ((size_t)l * 768 + 32 * (r % 24)) * QLORA, FIN(float, I_QLN) + l * QLORA, scr, F.lane); continue; } r -= 96;
            if (r < 64) { transpose_item(FIN(float, I_WUKV) + (size_t)l * KVLORA * 1024, KVLORA, 1024, 64 * (r / 32), 32 * (r % 32), WSP(bf16_t, WS_WUKV) + ((size_t)l * 1024 + 32 * (r % 32)) * KVLORA, FIN(float, I_KVLN) + l * KVLORA, scr, F.lane); continue; } r -= 64;
            transpose_item(FIN(float, I_WOUT) + (size_t)l * DM * DM, DM, DM, 64 * (r / 32), 32 * (r % 32), WSP(bf16_t, WS_WOUT) + ((size_t)l * DM + 32 * (r % 32)) * DM, nullptr, scr, F.lane); continue; }
        if (grp == 2 || grp == 3) continue;
        if (grp == 4) { down_item(FIN(float, I_FW2), WSP(bf16_t, WS_WFD), r, scr, F.lane); continue; }
        const int e = (grp - 5) / 3, wh = (grp - 5) % 3;
        if (wh == 2) down_item(FIN(float, I_MW2) + (size_t)e * DFF * DM, WSP(bf16_t, WS_WMD) + (size_t)e * DM * DFF, r, scr, F.lane);
    }
    const int gt = F.vcu * NTHR + F.tid, NGT = F.G * NTHR;
    for (int i = gt; i < 2 * 64 * DM / 16; i += NGT) { const int l = i / (64 * DM / 16), o = i % (64 * DM / 16); *(u32x4*)((signed char*)(F.ws + WS_WIN) + ((size_t)l * D_INP + D_IN) * DM + (size_t)o * 16) = (u32x4){0u, 0u, 0u, 0u}; }
    for (int i = gt; i < 2 * 64; i += NGT) WSP(float, WS_SBIN)[(i >> 6) * D_INP + D_IN + (i & 63)] = 0.f;
    for (int i = gt; i < 2 * NGRP * CHUNK * CHUNK; i += NGT) { const int t = (i >> 7) & 127, s = i & 127; WSP(bf16_t, WS_SGUW)[i] = (bf16_t)f2bf(s <= t ? FIN(float, I_SGUW)[i] : 0.f); }
    for (int it = gt; it < NTOK * 4; it += NGT) {
        const int tok = it >> 2, i0 = 8 * (it & 3);
        const double p = (double)FIN(int, I_POS)[tok]; const double rr = 0.74989420933245582730;   double inv = (i0 == 0) ? 1.0 : (i0 == 8) ? 0.1 : (i0 == 16) ? 0.01 : 0.001;
        float* co = WSP(float, WS_COS) + (size_t)tok * 32; float* si = WSP(float, WS_SIN) + (size_t)tok * 32;
        for (int i = i0; i < i0 + 8; ++i) {
            const double ang = p * inv; inv *= rr;
            const double q = __builtin_rint(ang * 0.63661977236758134308);
            double y = __builtin_fma(-q, 1.57079632679489655800, ang); y = __builtin_fma(-q, 6.12323399573676603587e-17, y);
            const double y2 = y * y;
            double sn = -7.6471637318198164759e-13; sn = sn * y2 + 1.6059043836821614599e-10; sn = sn * y2 - 2.5052108385441718775e-08; sn = sn * y2 + 2.7557319223985890653e-06; sn = sn * y2 - 1.9841269841269841270e-04; sn = sn * y2 + 8.3333333333333333333e-03; sn = sn * y2 - 1.6666666666666666667e-01; sn = y + y * y2 * sn;
            double cs = 4.7794773323873852974e-14; cs = cs * y2 - 1.1470745597729724714e-11; cs = cs * y2 + 2.0876756987868098979e-09; cs = cs * y2 - 2.7557319223985890653e-07; cs = cs * y2 + 2.4801587301587301587e-05; cs = cs * y2 - 1.3888888888888888889e-03; cs = cs * y2 + 4.1666666666666666667e-02; cs = cs * y2 - 0.5; cs = 1.0 + y2 * cs;
            const int qi = (int)((long long)q & 3);
            const double c2 = (qi == 0) ? cs : (qi == 1) ? -sn : (qi == 2) ? -cs : sn;
            const double s2 = (qi == 0) ? sn : (qi == 1) ? cs : (qi == 2) ? -sn : -cs;
            co[i] = (float)c2; si[i] = (float)s2;
        }
    }
}

#define NTL(p) __builtin_nontemporal_load(p)
template <bool ROUTE, bool OUT8, bool XBF>
__device__ __forceinline__ void norm_phase(const Frame& F0, const void* xv, const float* gain, const float* shift, const float* scale, bf16_t* out, int moe_layer) {
    static_assert(OUT8 || !XBF, "bf16 input rows are only written as int8");
    const float* x = (const float*)xv; const bf16_t* xb = (const bf16_t*)xv;
#define NCOL(j) (XBF ? 8 * F.lane + 512 * ((j) >> 1) + 4 * ((j) & 1) : 4 * F.lane + 256 * (j))
    Frame F = phase_frame(F0);
    LAS float* rw = (LAS float*)F.lds;
    LAS int* eL = (LAS int*)(F.lds + 32768);
    if (ROUTE) { const float* R = FIN(float, I_RW) + (size_t)moe_layer * DM * NEXP; for (int i = F.tid; i < DM * NEXP; i += NTHR) rw[(i & 7) * DM + (i >> 3)] = R[i]; __syncthreads(); }
    for (int wg = F.vcu; wg < NTOK / 128; wg += F.G) {
        const int b = wg >> 5;
        f32x4 gs[4], sh[4];
#pragma unroll
        for (int j = 0; j < 4; ++j) { const int col = NCOL(j); const f32x4 g = *(const f32x4*)(gain + col), sc = *(const f32x4*)(scale + (size_t)b * (NMOD * DM) + col); gs[j] = g * (sc + 1.0f); sh[j] = *(const f32x4*)(shift + (size_t)b * (NMOD * DM) + col); }
        f32x4 vn[XBF ? 1 : 4]; u32x4 rn[XBF ? 2 : 1], r1[XBF ? 2 : 1], r2[XBF ? 2 : 1], r3[XBF ? 2 : 1];
        if constexpr (XBF) { const u32x4* xr = (const u32x4*)(xb + (size_t)(wg * 128 + F.wave * 16) * DM) + F.lane; rn[0] = NTL(xr); rn[1] = NTL(xr + 64); r1[0] = NTL(xr + 128); r1[1] = NTL(xr + 192); r2[0] = NTL(xr + 256); r2[1] = NTL(xr + 320); r3[0] = NTL(xr + 384); r3[1] = NTL(xr + 448); }
        else { const f32x4* xr = (const f32x4*)(x + (size_t)(wg * 128 + F.wave * 16) * DM) + F.lane;
#pragma unroll
          for (int j = 0; j < 4; ++j) vn[j] = NTL(xr + 64 * j); }
        for (int rr = 0; rr < 16; ++rr) {
            const int row = wg * 128 + F.wave * 16 + rr;
            f32x4 v[4]; float ss = 0.f;
            if constexpr (XBF) {
                v[0] = bf4lo(rn[0]); v[1] = bf4hi(rn[0]); v[2] = bf4lo(rn[1]); v[3] = bf4hi(rn[1]);
                rn[0] = r1[0]; rn[1] = r1[1]; r1[0] = r2[0]; r1[1] = r2[1]; r2[0] = r3[0]; r2[1] = r3[1];
                if (rr + 4 < 16) { const u32x4* xr = (const u32x4*)(xb + (size_t)(row + 4) * DM) + F.lane; r3[0] = NTL(xr); r3[1] = NTL(xr + 64); }
            } else {
#pragma unroll
                for (int j = 0; j < 4; ++j) v[j] = vn[j];
                if (rr + 1 < 16) { const f32x4* xr = (const f32x4*)(x + (size_t)(row + 1) * DM) + F.lane;
#pragma unroll
                    for (int j = 0; j < 4; ++j) vn[j] = NTL(xr + 64 * j); }
            }
#pragma unroll
            for (int j = 0; j < 4; ++j) ss += (v[j].x * v[j].x + v[j].y * v[j].y) + (v[j].z * v[j].z + v[j].w * v[j].w);
            const float rstd = __builtin_amdgcn_rsqf(wave_sum(ss, F.lane) * (1.0f / DM) + EPS);
#pragma unroll
            for (int j = 0; j < 4; ++j) v[j] = v[j] * rstd * gs[j] + sh[j];
            if constexpr (OUT8) {
                float am = 0.f;
#pragma unroll
                for (int j = 0; j < 4; ++j) am = fmaxf(am, fmaxf(fmaxf(fabsf(v[j].x), fabsf(v[j].y)), fmaxf(fabsf(v[j].z), fabsf(v[j].w))));
                am = wave_max(am, F.lane); const float inv = am > 0.f ? 127.0f * __builtin_amdgcn_rcpf(am) : 0.f;
                if constexpr (XBF) { u32x2* o8 = (u32x2*)((signed char*)out + (size_t)row * DM) + F.lane;
#pragma unroll
                    for (int j2 = 0; j2 < 2; ++j2) { u32x2 w; w.x = pack_i8x4(v[2 * j2].x * inv, v[2 * j2].y * inv, v[2 * j2].z * inv, v[2 * j2].w * inv); w.y = pack_i8x4(v[2 * j2 + 1].x * inv, v[2 * j2 + 1].y * inv, v[2 * j2 + 1].z * inv, v[2 * j2 + 1].w * inv); o8[64 * j2] = w; }
                } else { unsigned* o4 = (unsigned*)((signed char*)out + (size_t)row * DM) + F.lane;
#pragma unroll
                    for (int j = 0; j < 4; ++j) o4[64 * j] = pack_i8x4(v[j].x * inv, v[j].y * inv, v[j].z * inv, v[j].w * inv); }
                if (F.lane == 0) WSP(float, WS_SA)[row] = am * (1.0f / 127.0f);
            } else {
                u32x2* o8 = (u32x2*)(out + (size_t)row * DM) + F.lane;
#pragma unroll
                for (int j = 0; j < 4; ++j) { u32x2 w; w.x = pk2(v[j].x, v[j].y); w.y = pk2(v[j].z, v[j].w); o8[64 * j] = w; }
            }
            if (ROUTE) {
                float pe[NEXP];
#pragma unroll
                for (int e = 0; e < NEXP; ++e) { float s = 0.f;
#pragma unroll
                    for (int j = 0; j < 4; ++j) { const f32x4 w = *(const LAS f32x4*)(rw + e * DM + NCOL(j)); s += (v[j].x * w.x + v[j].y * w.y) + (v[j].z * w.z + v[j].w * w.w); }
                    pe[e] = s; }
                const bool b5 = (F.lane & 32) != 0, b4 = (F.lane & 16) != 0, b3 = (F.lane & 8) != 0;
                float q4[4];
#pragma unroll
                for (int k = 0; k < 4; ++k) { const float keep = b5 ? pe[4 + k] : pe[k], offer = b5 ? pe[k] : pe[4 + k]; q4[k] = keep + __builtin_bit_cast(float, __builtin_amdgcn_ds_bpermute((F.lane ^ 32) << 2, __builtin_bit_cast(int, offer))); }
                float q2[2];
#pragma unroll
                for (int k = 0; k < 2; ++k) { const float keep = b4 ? q4[2 + k] : q4[k], offer = b4 ? q4[k] : q4[2 + k]; q2[k] = keep + __builtin_bit_cast(float, __builtin_amdgcn_ds_bpermute((F.lane ^ 16) << 2, __builtin_bit_cast(int, offer))); }
                float q1; { const float keep = b3 ? q2[1] : q2[0], offer = b3 ? q2[0] : q2[1]; q1 = keep + __builtin_bit_cast(float, __builtin_amdgcn_ds_bpermute((F.lane ^ 8) << 2, __builtin_bit_cast(int, offer))); }
#pragma unroll
                for (int o = 4; o >= 1; o >>= 1) q1 += __builtin_bit_cast(float, __builtin_amdgcn_ds_bpermute((F.lane ^ o) << 2, __builtin_bit_cast(int, q1)));
                float lg[NEXP];
#pragma unroll
                for (int e = 0; e < NEXP; ++e) lg[e] = __builtin_bit_cast(float, __builtin_amdgcn_readlane(__builtin_bit_cast(int, q1), 8 * e));
                int e0 = 0; float v0 = lg[0];
#pragma unroll
                for (int e = 1; e < NEXP; ++e) if (lg[e] > v0) { v0 = lg[e]; e0 = e; }
                int e1 = -1; float v1 = -INFINITY;
#pragma unroll
                for (int e = 0; e < NEXP; ++e) if (e != e0 && lg[e] > v1) { v1 = lg[e]; e1 = e; }
                if (e1 < 0) e1 = (e0 + 1) & 7;
                const float w0 = 1.0f / (1.0f + __expf(v1 - v0));
                if (F.lane == 0) { WSP(int, WS_RTE)[row] = e0 | (e1 << 8); WSP(float, WS_RTW)[2 * row] = w0; WSP(float, WS_RTW)[2 * row + 1] = 1.0f - w0; eL[F.wave * 16 + rr] = e0 | (e1 << 8); }
            }
        }
        if (ROUTE) {
            __syncthreads();
            if (F.tid < 128) {
                const int ee = eL[F.tid]; LAS int* cw = eL + 128;
#pragma unroll
                for (int e = 0; e < NEXP; ++e) { const int c0 = __popcll(__ballot((ee & 0xff) == e)), c1 = __popcll(__ballot(((ee >> 8) & 0xff) == e)); if (F.lane == 0) { cw[F.wave * 16 + e] = c0; cw[F.wave * 16 + 8 + e] = c1; } }
            }
            __syncthreads();
            if (F.tid < 16) WSP(int, WS_CNT)[wg * 16 + F.tid] = eL[128 + F.tid] + eL[128 + 16 + F.tid];
            __syncthreads();
        }
    }
}
#undef NCOL
__device__ __forceinline__ void route_phase(const Frame& F0) {
    Frame F = phase_frame(F0);
    LAS int* part = (LAS int*)F.lds;
    LAS int* tot = (LAS int*)(F.lds + 4096);
    LAS int* cw = (LAS int*)(F.lds + 8192);
    const unsigned* cnt = WSP(const unsigned, WS_CNT);
    for (int wg = F.vcu; wg < NTOK / 128; wg += F.G) {
        { const int t = F.tid & 15, p = F.tid >> 4; int sa = 0, sp = 0;
#pragma unroll
          for (int k = 0; k < 8; ++k) { const int w2 = 8 * p + k; const int v = (int)ld_agent(cnt + w2 * 16 + t); sa += v; sp += (w2 < wg) ? v : 0; }
          part[(p * 16 + t) * 2] = sa; part[(p * 16 + t) * 2 + 1] = sp; }
        int ee = 0, rank0 = 0, rank1 = 0; float w0 = 0.f, w1 = 0.f;
        if (F.tid < 128) {
            const int tok = wg * 128 + F.tid;
            ee = (int)ld_agent(WSP(const unsigned, WS_RTE) + tok);
            w0 = __builtin_bit_cast(float, ld_agent(WSP(const unsigned, WS_RTW) + 2 * tok)); w1 = __builtin_bit_cast(float, ld_agent(WSP(const unsigned, WS_RTW) + 2 * tok + 1));
            const unsigned long long lt = (1ull << F.lane) - 1ull;
#pragma unroll
            for (int e = 0; e < NEXP; ++e) {
                const unsigned long long m0 = __ballot((ee & 0xff) == e), m1 = __ballot(((ee >> 8) & 0xff) == e);
                if ((ee & 0xff) == e) rank0 = __popcll(m0 & lt);
                if (((ee >> 8) & 0xff) == e) rank1 = __popcll(m1 & lt);
                if (F.tid == 0) { cw[e] = __popcll(m0); cw[8 + e] = __popcll(m1); }
            }
        }
        __syncthreads();
        if (F.tid < 16) { int sa = 0, sp = 0; for (int p = 0; p < 32; ++p) { sa += part[(p * 16 + F.tid) * 2]; sp += part[(p * 16 + F.tid) * 2 + 1]; } tot[F.tid] = sp; tot[16 + F.tid] = sa; }
        __syncthreads();
        if (F.tid < 16) { const int s = F.tid >> 3, e = F.tid & 7; int base = 0; for (int e2 = 0; e2 < e; ++e2) base += (tot[16 + s * 8 + e2] + 255) & ~255; tot[32 + F.tid] = base; }
        __syncthreads();
        if (F.tid < 128) {
            const int tok = wg * 128 + F.tid; const int e0 = ee & 0xff, e1 = (ee >> 8) & 0xff;
            const int p0 = tot[32 + e0] + tot[e0] + rank0 + (F.tid >= 64 ? cw[e0] : 0), p1 = tot[32 + 8 + e1] + tot[8 + e1] + rank1 + (F.tid >= 64 ? cw[8 + e1] : 0);
            const float sat = WSP(const float, WS_SA)[tok];
            WSP(int, WS_RMAP)[p0] = tok; WSP(float, WS_RGATE)[p0] = w0; WSP(float, WS_RSA)[p0] = sat;
            WSP(int, WS_RMAP)[SLOTROWS + p1] = tok; WSP(float, WS_RGATE)[SLOTROWS + p1] = w1; WSP(float, WS_RSA)[SLOTROWS + p1] = sat;
        }
        if (wg == 0 && F.tid < 16) {
            const int s = F.tid >> 3, e = F.tid & 7; const int base = tot[32 + F.tid], all = tot[16 + F.tid], end = base + ((all + 255) & ~255);
            int* rmap = WSP(int, WS_RMAP) + s * SLOTROWS; float* rgate = WSP(float, WS_RGATE) + s * SLOTROWS;
#pragma clang loop vectorize(disable) unroll(disable)
            for (int p = base + all; p < end; ++p) { rmap[p] = -1; rgate[p] = 0.f; WSP(float, WS_RSA)[s * SLOTROWS + p] = 0.f; }
            int* tab = WSP(int, WS_TAB);
#pragma clang loop vectorize(disable) unroll(disable)
            for (int pm = base >> 8; pm < (end >> 8); ++pm) tab[16 + 136 * s + pm] = e;
            if (e == 7) tab[s] = end >> 8;
        }
        __syncthreads();
    }
}
constexpr int TAIL_S = 11;
__device__ __forceinline__ int moe_prep(const Frame& F0, int slot, int mode) {
    Frame F = phase_frame(F0);
    LAS int* ul = (LAS int*)(F.lds + LDS_UL_OFF + (mode == 2 ? 256 : 0)); LAS int* idx = (LAS int*)(F.lds + LDS_IDX_OFF);
    const unsigned* tab = WSP(const unsigned, WS_TAB); const unsigned* rmap = WSP(const unsigned, WS_RMAP) + slot * SLOTROWS;
    const int nT = (int)ld_agent(tab + slot);
    int n = 0;
    if (mode == 2) {
        const int items = (nT - 128) * 4 * TAIL_S;
        for (int i = 0; i < 2; ++i) { const int it = (int)blockIdx.x + i * F.G; if (it >= items) break; n = i + 1;
            const int un = it / TAIL_S, kc = it % TAIL_S, pm = 128 + (un >> 2), pn = un & 3;
            if (F.tid == 0) { ul[4 * i] = pm; ul[4 * i + 1] = pn; ul[4 * i + 2] = (int)ld_agent(tab + 16 + 136 * slot + pm); ul[4 * i + 3] = kc; } }
    } else {
        pg8::StaticOrder so; so.init(mode == 0 ? nT : 128, mode == 0 ? 22 : 4, F.G, (int)blockIdx.x);
        { const long last = (long)so.nwg - 1 - so.c; n = last < 0 ? 0 : (int)(last / so.G) + 1; if (n > 12) n = 12; }
        if (F.tid < n) { int pm, pn; so.tile(F.tid, pm, pn); ul[4 * F.tid] = pm; ul[4 * F.tid + 1] = pn; ul[4 * F.tid + 2] = (int)ld_agent(tab + 16 + 136 * slot + pm); ul[4 * F.tid + 3] = 0; }
        if (mode == 0) {
            __syncthreads();
            for (int j = F.tid; j < n * 256; j += NTHR) { const int t = (int)ld_agent(rmap + ul[4 * (j >> 8)] * 256 + (j & 255)); idx[j] = t < 0 ? 0 : t; }
        }
    }
    __syncthreads();
    return n;
}
constexpr size_t WS_SCRA = WS_WIN, WS_SCRB = WS_ACT + (size_t)SLOTROWS * DFF * 2; constexpr int SCRA_ITEMS = 220;
static_assert(WS_SCRA + (size_t)SCRA_ITEMS * 131072 <= WS_WMU && WS_SCRB + (size_t)(7 * 4 * TAIL_S - SCRA_ITEMS) * 131072 <= WS_END, "split-K scratch");
__device__ __forceinline__ size_t scr_off(int item) { return item < SCRA_ITEMS ? WS_SCRA + (size_t)item * 131072 : WS_SCRB + (size_t)(item - SCRA_ITEMS) * 131072; }
struct EpiPartial {
    static constexpr bool PERM = false;
    unsigned char* ws;
    __device__ __forceinline__ void operator()(const f32x4 (&acc)[2][2][4][2], const pg8::Unit& u, int wr, int wc, int fr, int fq) const {
        const int item = ((u.pm - 128) * 4 + u.pn) * TAIL_S + (u.aux & 15); int ln = fq * 16 + fr; asm volatile("" : "+v"(ln)); const int tid = (wr * 4 + wc) * 64 + ln;
        u32x4* dst = (u32x4*)(ws + scr_off(item)) + tid;
        float one; asm volatile("v_mov_b32 %0, 1.0" : "=v"(one));
#pragma unroll
        for (int ai = 0; ai < 2; ++ai)
#pragma unroll
            for (int bj = 0; bj < 2; ++bj)
#pragma unroll
                for (int m = 0; m < 4; ++m) { const f32x4 v0 = acc[ai][bj][m][0] * one, v1 = acc[ai][bj][m][1] * one;
                    u32x4 w; w.x = pk2(v0[0], v0[1]); w.y = pk2(v0[2], v0[3]); w.z = pk2(v1[0], v1[1]); w.w = pk2(v1[2], v1[3]);
                    dst[((ai * 2 + bj) * 4 + m) * 512] = w; }
    }
};
template <bool FINAL> __device__ __forceinline__ void moe_tail_reduce(const Frame& F0, int slot, const float* g2) {
    Frame F = phase_frame(F0);
    const int nT = (int)ld_agent(WSP(const unsigned, WS_TAB) + slot);
    const int nitems = (nT - 128) * 4 * 16;
    const int* rowmap = WSP(const int, WS_RMAP) + slot * SLOTROWS; const float* rowgate = WSP(const float, WS_RGATE) + slot * SLOTROWS;
    const int wid = F.wave, wr = wid >> 2, wc = wid & 3, fr = F.lane & 15, fq = F.lane >> 4;
    for (int it = blockIdx.x; it < nitems; it += F.G) {
        const int un = it >> 4, rgi = it & 15, ai = rgi >> 3, bj = (rgi >> 2) & 1, m = rgi & 3, pm = 128 + (un >> 2), pn = un & 3;
        f32x4 s0 = {0.f, 0.f, 0.f, 0.f}, s1 = {0.f, 0.f, 0.f, 0.f};
#pragma unroll
        for (int kc = 0; kc < TAIL_S; ++kc) { const u32x4 w = *((const u32x4*)(F.ws + scr_off(un * TAIL_S + kc)) + rgi * 512 + F.tid);
            s0.x += bflo(w.x); s0.y += bfhi(w.x); s0.z += bflo(w.y); s0.w += bfhi(w.y); s1.x += bflo(w.z); s1.y += bfhi(w.z); s1.z += bflo(w.w); s1.w += bfhi(w.w); }
        const int row = pm * 256 + ai * 128 + wr * 64 + m * 16 + fr; const int tok = rowmap[row]; const float gt = rowgate[row];
        if (tok >= 0) { const int col = pn * 256 + bj * 128 + wc * 32 + 4 * fq; bf16_t* xp = WSP(bf16_t, WS_XB) + (size_t)tok * DM + col; const float* gp = g2 + (size_t)(tok >> 12) * (NMOD * DM) + col;
            const u32x2 x0 = *(const u32x2*)xp, x1 = *(const u32x2*)(xp + 16);
            const f32x4 o0 = (f32x4){bflo(x0.x), bfhi(x0.x), bflo(x0.y), bfhi(x0.y)} + *(const f32x4*)gp * gt * s0, o1 = (f32x4){bflo(x1.x), bfhi(x1.x), bflo(x1.y), bfhi(x1.y)} + *(const f32x4*)(gp + 16) * gt * s1;
            if constexpr (FINAL) { float* op = (float*)F.out + (size_t)tok * DM + col; *(f32x4*)op = o0; *(f32x4*)(op + 16) = o1; }
            else { u32x2 w0, w1; w0.x = pk2(o0[0], o0[1]); w0.y = pk2(o0[2], o0[3]); w1.x = pk2(o1[0], o1[1]); w1.y = pk2(o1[2], o1[3]); *(u32x2*)xp = w0; *(u32x2*)(xp + 16) = w1; } }
    }
}

constexpr int VS = 1088;
constexpr int WQS = 528, WKS = 272;
constexpr int STQ_OFF = 102400, STQ_W = 6656, STK_OFF = 69632, STK_W = 8704;
constexpr int GAIN_OFF = 155648;
static_assert(STQ_OFF + 8 * STQ_W <= GAIN_OFF && STK_OFF + 8 * STK_W <= GAIN_OFF && 128 * VS <= GAIN_OFF && GAIN_OFF + 2 * 192 * 4 <= MISC_OFF, "gain table");
static_assert(192 * WQS <= STQ_OFF && STQ_OFF + 8 * STQ_W <= MISC_OFF && 256 * WKS <= STK_OFF && STK_OFF + 8 * STK_W <= MISC_OFF && 128 * VS <= MISC_OFF, "mid-phase LDS");
__device__ __forceinline__ float ssq8(u32x4 w) { return (bflo(w.x) * bflo(w.x) + bfhi(w.x) * bfhi(w.x)) + (bflo(w.y) * bflo(w.y) + bfhi(w.y) * bfhi(w.y)) + (bflo(w.z) * bflo(w.z) + bfhi(w.z) * bfhi(w.z)) + (bflo(w.w) * bflo(w.w) + bfhi(w.w) * bfhi(w.w)); }
template <int NB, int RS>
__device__ __forceinline__ void store_rows_via_lds(LAS unsigned char* stg, const f32x16& v0, const f32x16& v1, const f32x16& v2, const f32x16& v3, float f, const LAS float* gain, bf16_t* dst, int ld, int lane_) {
    int lane = lane_; asm volatile("" : "+v"(lane)); const int r = lane & 31, hi = lane >> 5;
#pragma unroll
    for (int nb = 0; nb < NB; ++nb) { const f32x16& v = nb == 0 ? v0 : nb == 1 ? v1 : nb == 2 ? v2 : v3;
#pragma unroll
        for (int g4 = 0; g4 < 4; ++g4) { f32x4 gq = {f, f, f, f}; if (gain) gq = *(const LAS f32x4*)(gain + 32 * nb + 8 * g4 + 4 * hi) * f;
            u32x2 w; w.x = pk2(v[4 * g4] * gq.x, v[4 * g4 + 1] * gq.y); w.y = pk2(v[4 * g4 + 2] * gq.z, v[4 * g4 + 3] * gq.w); *(LAS u32x2*)(stg + r * RS + (32 * nb + 8 * g4 + 4 * hi) * 2) = w; } }
    LDS_WAIT();
    constexpr int CPR = NB * 4;
#pragma unroll
    for (int i = 0; i < (32 * CPR) / 64; ++i) { const int idx = lane + 64 * i, row = idx / CPR, ch = idx % CPR; const u32x4 w = *(const LAS u32x4*)(stg + row * RS + ch * 16); *(u32x4*)(dst + (size_t)row * ld + ch * 8) = w; }
    LDS_WAIT();
}
__device__ __forceinline__ void mid_phase(const Frame& F0, int l) {
    Frame F = phase_frame(F0);
    const int lane = F.lane, wid = F.wave;
    { LAS float* gl = (LAS float*)(F.lds + GAIN_OFF); if (F.tid < 2 * QKH) gl[F.tid] = F.tid < QKH ? FIN(float, I_QN)[l * QKH + F.tid] : FIN(float, I_KN)[l * QKH + F.tid - QKH]; }
#ifndef NO_PART_A
    for (int ch = F.vcu; ch < NTOK / CHUNK; ch += F.G) {
        const int row0 = ch * CHUNK; const int r = lane & 31, hi = lane >> 5;
        const bf16_t* U = WSP(const bf16_t, WS_U); const bf16_t* GV = WSP(const bf16_t, WS_GV); bf16_t* CC = WSP(bf16_t, WS_H);
        const int g = wid; const bf16_t* Wg = WSP(const bf16_t, WS_SGUW) + (size_t)(l * NGRP + g) * CHUNK * CHUNK;
        bf16x8 wf[20];
#pragma unroll
        for (int mb = 0; mb < 4; ++mb)
#pragma unroll
            for (int ks = 0; ks <= 2 * mb + 1; ++ks) wf[mb * (mb + 1) + ks] = *(const bf16x8*)(Wg + (size_t)(32 * mb + r) * CHUNK + 16 * ks + 8 * hi);
        {
            const int c = lane & 7;
#pragma unroll 1
            for (int it = 0; it < 2; ++it) { const int t = wid * 16 + it * 8 + (lane >> 3);
                const u32x4* src = (const u32x4*)(GV + (size_t)(row0 + t) * SGU_W + 8 * c);
                u32x4 raw[8];
#pragma unroll
                for (int j = 0; j < 8; ++j) raw[j] = __builtin_nontemporal_load(src + 8 * j);
                float s = 0.f;
#pragma unroll
                for (int j = 0; j < 8; ++j) s += ((bflo(raw[j].x) + bfhi(raw[j].x)) + (bflo(raw[j].y) + bfhi(raw[j].y))) + ((bflo(raw[j].z) + bfhi(raw[j].z)) + (bflo(raw[j].w) + bfhi(raw[j].w)));
#pragma unroll
                for (int o = 1; o < 8; o <<= 1) s += __builtin_bit_cast(float, __builtin_amdgcn_ds_bpermute((lane ^ o) << 2, __builtin_bit_cast(int, s)));
                const float mean = s * (1.0f / SGU_W); float q = 0.f;
#pragma unroll
                for (int j = 0; j < 8; ++j) { const float d0 = bflo(raw[j].x) - mean, d1 = bfhi(raw[j].x) - mean, d2 = bflo(raw[j].y) - mean, d3 = bfhi(raw[j].y) - mean, d4 = bflo(raw[j].z) - mean, d5 = bfhi(raw[j].z) - mean, d6 = bflo(raw[j].w) - mean, d7 = bfhi(raw[j].w) - mean;
                    q += ((d0 * d0 + d1 * d1) + (d2 * d2 + d3 * d3)) + ((d4 * d4 + d5 * d5) + (d6 * d6 + d7 * d7)); }
#pragma unroll
                for (int o = 1; o < 8; o <<= 1) q += __builtin_bit_cast(float, __builtin_amdgcn_ds_bpermute((lane ^ o) << 2, __builtin_bit_cast(int, q)));
                const float rstd = __builtin_amdgcn_rsqf(q * (1.0f / SGU_W) + EPS);
#pragma unroll
                for (int j = 0; j < 8; ++j) { u32x4 w;
                    w.x = pk2((bflo(raw[j].x) - mean) * rstd, (bfhi(raw[j].x) - mean) * rstd); w.y = pk2((bflo(raw[j].y) - mean) * rstd, (bfhi(raw[j].y) - mean) * rstd);
                    w.z = pk2((bflo(raw[j].z) - mean) * rstd, (bfhi(raw[j].z) - mean) * rstd); w.w = pk2((bflo(raw[j].w) - mean) * rstd, (bfhi(raw[j].w) - mean) * rstd);
                    *(LAS u32x4*)(F.lds + t * VS + (8 * c + 64 * j) * 2) = w; }
            }
        }
        __syncthreads();
        {
            const int i16 = lane & 15, q4 = i16 >> 2, p4 = i16 & 3, g2 = (lane >> 4) & 1;
            const LAS unsigned char* vb = F.lds + (8 * hi + q4) * VS + (64 * g + 16 * g2 + 4 * p4) * 2;
            u32x4 uv[16];
#pragma unroll
            for (int i = 0; i < 16; ++i) uv[i] = __builtin_nontemporal_load((const u32x4*)(U + (size_t)(row0 + i * 8 + (lane >> 3)) * SGU_W + 64 * g + 8 * (lane & 7)));
            asm volatile("" ::: "memory");
#pragma unroll
            for (int mb = 3; mb >= 0; --mb) {
                f32x16 a0 = {}, a1 = {};
#pragma unroll
                for (int ks = 0; ks <= 2 * mb + 1; ++ks) {
                    const s16x4 l0 = vtr(vb + (16 * ks) * VS), h0 = vtr(vb + (16 * ks + 4) * VS), l1 = vtr(vb + (16 * ks) * VS + 64), h1 = vtr(vb + (16 * ks + 4) * VS + 64);
                    const bf16x8 b0 = {l0[0], l0[1], l0[2], l0[3], h0[0], h0[1], h0[2], h0[3]}, b1 = {l1[0], l1[1], l1[2], l1[3], h1[0], h1[1], h1[2], h1[3]};
                    a0 = __builtin_amdgcn_mfma_f32_32x32x16_bf16(wf[mb * (mb + 1) + ks], b0, a0, 0, 0, 0); a1 = __builtin_amdgcn_mfma_f32_32x32x16_bf16(wf[mb * (mb + 1) + ks], b1, a1, 0, 0, 0);
                }
                LDS_WAIT();
#pragma unroll
                for (int rg = 0; rg < 16; ++rg) { LAS bf16_t* sp = (LAS bf16_t*)(F.lds + (32 * mb + crow(rg, hi)) * VS + (64 * g + r) * 2); sp[0] = (bf16_t)f2bf(a0[rg]); sp[32] = (bf16_t)f2bf(a1[rg]); }
                asm volatile("" ::: "memory");
            }
            LDS_WAIT();
            const float* bg = FIN(float, I_SGUB) + (size_t)(l * NGRP + g) * CHUNK;
            const f32x4 gn0 = *(const f32x4*)(FIN(float, I_SGUN) + l * SGU_W + 64 * g + 8 * (lane & 7)), gn1 = *(const f32x4*)(FIN(float, I_SGUN) + l * SGU_W + 64 * g + 8 * (lane & 7) + 4);
#pragma unroll
            for (int i = 0; i < 16; ++i) { const int t = i * 8 + (lane >> 3), c8 = lane & 7;
                const u32x4 sv = *(const LAS u32x4*)(F.lds + t * VS + (64 * g + 8 * c8) * 2);
                const u32x4 uvi = uv[i]; const float bias = bg[t];
                u32x4 o; o.x = pk2(bflo(uvi.x) * (bflo(sv.x) * gn0.x + bias), bfhi(uvi.x) * (bfhi(sv.x) * gn0.y + bias)); o.y = pk2(bflo(uvi.y) * (bflo(sv.y) * gn0.z + bias), bfhi(uvi.y) * (bfhi(sv.y) * gn0.w + bias));
                o.z = pk2(bflo(uvi.z) * (bflo(sv.z) * gn1.x + bias), bfhi(uvi.z) * (bfhi(sv.z) * gn1.y + bias)); o.w = pk2(bflo(uvi.w) * (bflo(sv.w) * gn1.z + bias), bfhi(uvi.w) * (bfhi(sv.w) * gn1.w + bias));
                *(u32x4*)(CC + (size_t)(row0 + t) * DM + 64 * g + 8 * c8) = o; }
        }
        __syncthreads();
    }
#endif
#ifndef NO_PART_B
    for (int un = F.vcu; un < (NTOK / 512) * NH; un += F.G) {
        const int tg = un >> 2, h = un & 3;
        { const u32x4* src = (const u32x4*)(WSP(const bf16_t, WS_WUQ) + ((size_t)l * 768 + 192 * h) * QLORA); int t2 = F.tid; asm volatile("" : "+v"(t2));
#pragma unroll
          for (int i = 0; i < 12; ++i) { const int c = t2 + 512 * i; *(LAS u32x4*)(F.lds + (c >> 5) * WQS + (c & 31) * 16) = src[c]; } }
        __syncthreads();
#pragma unroll 1
        for (int blk = 0; blk < 2; ++blk) {
            int ln_ = lane; asm volatile("" : "+v"(ln_)); const int r = ln_ & 31, hi = ln_ >> 5;
            const int tblk = tg * 16 + wid * 2 + blk;
            const int tok = tblk * 32 + r; const int b = tok >> 12;
            u32x4 bq[16]; float ssl = 0.f;
            { const u32x4* cq = (const u32x4*)WSP(const bf16_t, WS_CQ) + ((size_t)tblk * 32 + hi) * 32 + r;
#pragma unroll
              for (int ks = 0; ks < 16; ++ks) bq[ks] = cq[ks * 64]; }
#pragma unroll
            for (int ks = 0; ks < 16; ++ks) ssl += ssq8(bq[ks]);
            asm volatile("" : "+v"(ssl));
            f32x16 acc[6];
#pragma unroll
            for (int nb = 0; nb < 6; ++nb) acc[nb] = f32x16{};
            const LAS unsigned char* wb = F.lds + r * WQS + 16 * hi; asm volatile("" : "+v"(wb));
            bf16x8 af[2][6];
#pragma unroll
            for (int nb = 0; nb < 6; ++nb) af[0][nb] = *(const LAS bf16x8*)(wb + nb * 32 * WQS);
#pragma unroll
            for (int ks = 0; ks < 16; ++ks) {
                if (ks + 1 < 16) {
#pragma unroll
                    for (int nb = 0; nb < 6; ++nb) af[(ks + 1) & 1][nb] = *(const LAS bf16x8*)(wb + nb * 32 * WQS + 32 * (ks + 1)); }
#pragma unroll
                for (int nb = 0; nb < 6; ++nb) acc[nb] = __builtin_amdgcn_mfma_f32_32x32x16_bf16(af[ks & 1][nb], __builtin_bit_cast(bf16x8, bq[ks]), acc[nb], 0, 0, 0);
                asm volatile("" : "+v"(wb) : "v"(acc[0][0]));
            }
            ssl = half_sum(ssl);
            const float rl = __builtin_amdgcn_rsqf(ssl * (1.0f / QLORA) + EPS);
            float ssq = 0.f;
#pragma unroll
            for (int nb = 0; nb < 6; ++nb)
#pragma unroll
                for (int rg = 0; rg < 16; ++rg) ssq += acc[nb][rg] * acc[nb][rg];
            ssq = half_sum(ssq);
            const float C2 = 0.07216878364870322f * 1.4426950408889634f;
            const float fq = C2 * rl * __builtin_amdgcn_rsqf(ssq * rl * rl * (1.0f / QKH) + EPS);
            const LAS float* qnp = (const LAS float*)(F.lds + GAIN_OFF);
            bf16_t* qo = WSP(bf16_t, WS_Q) + ((size_t)(b * NH + h) * SEQ + (tblk * 32 & 4095)) * QKH;
            LAS unsigned char* stg = F.lds + STQ_OFF + wid * STQ_W;
            store_rows_via_lds<3, 208>(stg, acc[0], acc[1], acc[2], acc[2], fq, qnp, qo, QKH, ln_);
            const GAS float* cs_g = (const GAS float*)WSP(const float, WS_COS) + (size_t)tok * 32; const GAS float* sn_g = (const GAS float*)WSP(const float, WS_SIN) + (size_t)tok * 32; asm volatile("" : "+v"(cs_g), "+v"(sn_g)); const float* cs = (const float*)cs_g; const float* sn = (const float*)sn_g;
            f32x4 cvs[4], svs[4];
#pragma unroll
            for (int g4 = 0; g4 < 4; ++g4) { cvs[g4] = *(const f32x4*)(cs + 8 * g4 + 4 * hi); svs[g4] = *(const f32x4*)(sn + 8 * g4 + 4 * hi); }
#pragma unroll
            for (int g4 = 0; g4 < 4; ++g4) { const int i0 = 8 * g4 + 4 * hi; const f32x4 n0 = *(const LAS f32x4*)(qnp + 96 + i0), n1 = *(const LAS f32x4*)(qnp + 128 + i0), n2 = *(const LAS f32x4*)(qnp + 160 + i0), cv = cvs[g4], sv = svs[g4];
#pragma unroll
                for (int j = 0; j < 4; ++j) { const float x1 = acc[4][4 * g4 + j] * fq * n1[j], x2 = acc[5][4 * g4 + j] * fq * n2[j]; acc[3][4 * g4 + j] *= fq * n0[j]; acc[4][4 * g4 + j] = x1 * cv[j] - x2 * sv[j]; acc[5][4 * g4 + j] = x2 * cv[j] + x1 * sv[j]; } }
            store_rows_via_lds<3, 208>(stg, acc[3], acc[4], acc[5], acc[5], 1.0f, nullptr, qo + 96, QKH, ln_);
        }
        __syncthreads();
        { const u32x4* src = (const u32x4*)(WSP(const bf16_t, WS_WUKV) + ((size_t)l * 1024 + 256 * h) * KVLORA); int t2 = F.tid; asm volatile("" : "+v"(t2));
#pragma unroll
          for (int i = 0; i < 8; ++i) { const int c = t2 + 512 * i; *(LAS u32x4*)(F.lds + (c >> 4) * WKS + (c & 15) * 16) = src[c]; } }
        __syncthreads();
#pragma unroll 1
        for (int blk = 0; blk < 2; ++blk) {
            int ln_ = lane; asm volatile("" : "+v"(ln_)); const int r = ln_ & 31, hi = ln_ >> 5;
            const int tblk = tg * 16 + wid * 2 + blk;
            const int tok = tblk * 32 + r; const int b = tok >> 12;
            u32x4 bk[8]; float ssl = 0.f;
            { const u32x4* ck = (const u32x4*)WSP(const bf16_t, WS_CKV) + ((size_t)tblk * 16 + hi) * 32 + r;
#pragma unroll
              for (int ks = 0; ks < 8; ++ks) bk[ks] = ck[ks * 64]; }
#pragma unroll
            for (int ks = 0; ks < 8; ++ks) ssl += ssq8(bk[ks]);
            asm volatile("" : "+v"(ssl));
            f32x16 rp[2];
            { const u32x2* kr = (const u32x2*)WSP(const bf16_t, WS_KR) + ((size_t)tblk * 16 + hi) * 32 + r;
#pragma unroll
              for (int g4 = 0; g4 < 4; ++g4) { const u32x2 a = kr[(2 * g4) * 32], c = kr[(8 + 2 * g4) * 32];
                rp[0][4 * g4] = bflo(a.x); rp[0][4 * g4 + 1] = bfhi(a.x); rp[0][4 * g4 + 2] = bflo(a.y); rp[0][4 * g4 + 3] = bfhi(a.y);
                rp[1][4 * g4] = bflo(c.x); rp[1][4 * g4 + 1] = bfhi(c.x); rp[1][4 * g4 + 2] = bflo(c.y); rp[1][4 * g4 + 3] = bfhi(c.y); } }
            f32x16 acc[4];
#pragma unroll
            for (int nb = 0; nb < 4; ++nb) acc[nb] = f32x16{};
            const LAS unsigned char* wb = F.lds + r * WKS + 16 * hi; asm volatile("" : "+v"(wb));
            bf16x8 af[2][4];
#pragma unroll
            for (int nb = 0; nb < 4; ++nb) af[0][nb] = *(const LAS bf16x8*)(wb + nb * 32 * WKS);
#pragma unroll
            for (int ks = 0; ks < 8; ++ks) {
                if (ks + 1 < 8) {
#pragma unroll
                    for (int nb = 0; nb < 4; ++nb) af[(ks + 1) & 1][nb] = *(const LAS bf16x8*)(wb + nb * 32 * WKS + 32 * (ks + 1)); }
#pragma unroll
                for (int nb = 0; nb < 4; ++nb) acc[nb] = __builtin_amdgcn_mfma_f32_32x32x16_bf16(af[ks & 1][nb], __builtin_bit_cast(bf16x8, bk[ks]), acc[nb], 0, 0, 0);
                asm volatile("" : "+v"(wb) : "v"(acc[0][0]));
            }
            ssl = half_sum(ssl);
            const float rl = __builtin_amdgcn_rsqf(ssl * (1.0f / KVLORA) + EPS);
            float ssq = 0.f, ssr = 0.f;
#pragma unroll
            for (int nb = 0; nb < 4; ++nb)
#pragma unroll
                for (int rg = 0; rg < 16; ++rg) ssq += acc[nb][rg] * acc[nb][rg];
#pragma unroll
            for (int j = 0; j < 16; ++j) ssr += rp[0][j] * rp[0][j] + rp[1][j] * rp[1][j];
            ssq = ssq * rl * rl + ssr;
            ssq = half_sum(ssq);
            const float rn = __builtin_amdgcn_rsqf(ssq * (1.0f / QKH) + EPS);
            const LAS float* knp = (const LAS float*)(F.lds + GAIN_OFF) + QKH;
            bf16_t* ko = WSP(bf16_t, WS_K) + ((size_t)(b * NH + h) * SEQ + (tblk * 32 & 4095)) * QKH;
            LAS unsigned char* stg = F.lds + STK_OFF + wid * STK_W;
            store_rows_via_lds<4, 272>(stg, acc[0], acc[1], acc[2], acc[3], rl * rn, knp, ko, QKH, ln_);
            const GAS float* cs_g = (const GAS float*)WSP(const float, WS_COS) + (size_t)tok * 32; const GAS float* sn_g = (const GAS float*)WSP(const float, WS_SIN) + (size_t)tok * 32; asm volatile("" : "+v"(cs_g), "+v"(sn_g)); const float* cs = (const float*)cs_g; const float* sn = (const float*)sn_g;
            f32x4 cvs[4], svs[4];
#pragma unroll
            for (int g4 = 0; g4 < 4; ++g4) { cvs[g4] = *(const f32x4*)(cs + 8 * g4 + 4 * hi); svs[g4] = *(const f32x4*)(sn + 8 * g4 + 4 * hi); }
#pragma unroll
            for (int g4 = 0; g4 < 4; ++g4) { const int i0 = 8 * g4 + 4 * hi; const f32x4 n1 = *(const LAS f32x4*)(knp + 128 + i0), n2 = *(const LAS f32x4*)(knp + 160 + i0), cv = cvs[g4], sv = svs[g4];
#pragma unroll
                for (int j = 0; j < 4; ++j) { const float y1 = rp[0][4 * g4 + j] * rn * n1[j], y2 = rp[1][4 * g4 + j] * rn * n2[j]; rp[0][4 * g4 + j] = y1 * cv[j] - y2 * sv[j]; rp[1][4 * g4 + j] = y2 * cv[j] + y1 * sv[j]; } }
            store_rows_via_lds<2, 272>(stg, rp[0], rp[1], rp[1], rp[1], 1.0f, nullptr, ko + 128, QKH, ln_);
#pragma unroll
            for (int nb = 0; nb < 4; ++nb) acc[nb] = f32x16{};
#pragma unroll
            for (int nb = 0; nb < 4; ++nb) af[0][nb] = *(const LAS bf16x8*)(wb + (128 + nb * 32) * WKS);
#pragma unroll
            for (int ks = 0; ks < 8; ++ks) {
                if (ks + 1 < 8) {
#pragma unroll
                    for (int nb = 0; nb < 4; ++nb) af[(ks + 1) & 1][nb] = *(const LAS bf16x8*)(wb + (128 + nb * 32) * WKS + 32 * (ks + 1)); }
#pragma unroll
                for (int nb = 0; nb < 4; ++nb) acc[nb] = __builtin_amdgcn_mfma_f32_32x32x16_bf16(af[ks & 1][nb], __builtin_bit_cast(bf16x8, bk[ks]), acc[nb], 0, 0, 0);
                asm volatile("" : "+v"(wb) : "v"(acc[0][0]));
            }
            bf16_t* vo = WSP(bf16_t, WS_V) + ((size_t)(b * NH + h) * SEQ + (tblk * 32 & 4095)) * VH;
            store_rows_via_lds<4, 272>(stg, acc[0], acc[1], acc[2], acc[3], rl, nullptr, vo, VH, ln_);
        }
        __syncthreads();
    }
#endif
}

constexpr int KST = 400, VST = 320;
constexpr int ATT_KOFF = 0, ATT_VOFF = 2 * 64 * KST, ATT_BYTES = ATT_VOFF + 2 * 64 * VST;
static_assert(ATT_BYTES <= RING_BYTES && 64 * KST == 25 * 1024 && 64 * VST == 20 * 1024, "attention LDS: a K tile is 25 and a V tile 20 LDS-DMA pieces of 1 KiB");
__device__ __forceinline__ float max3f(float a, float b, float c) { float r; asm("v_max3_f32 %0, %1, %2, %3" : "=v"(r) : "v"(a), "v"(b), "v"(c)); return r; }
__device__ __forceinline__ float max2f(float a, float b) { float r; asm("v_max_f32_e32 %0, %1, %2" : "=v"(r) : "v"(a), "v"(b)); return r; }
__device__ __forceinline__ void glds16s(const void* sbase, unsigned voff, unsigned lds_dst) { unsigned keep;
    asm volatile("s_mov_b32 %0, m0\n\ts_mov_b32 m0, %3\n\ts_nop 4\n\tglobal_load_lds_dwordx4 %1, %2\n\ts_mov_b32 m0, %0" : "=&s"(keep) : "v"(voff), "s"(sbase), "s"(lds_dst) : "memory"); }
__device__ __forceinline__ void glds16(const void* gsrc, unsigned lds_dst) { unsigned keep;
    asm volatile("s_mov_b32 %0, m0\n\ts_mov_b32 m0, %2\n\ts_nop 0\n\tglobal_load_lds_dwordx4 %1, off\n\ts_mov_b32 m0, %0" : "=&s"(keep) : "v"(gsrc), "s"(lds_dst) : "memory"); }
__device__ __forceinline__ void attn_unit(const Frame& F, int b, int h, int qb, bool bounded) {
    const int tid = F.tid, lane = F.lane, wid = F.wave, r = lane & 31, hi = lane >> 5;
    const bf16_t* Qh = WSP(const bf16_t, WS_Q) + (size_t)(b * NH + h) * SEQ * QKH;
    const char* Kh = (const char*)(WSP(const bf16_t, WS_K) + (size_t)(b * NH + h) * SEQ * QKH);
    const char* Vh = (const char*)(WSP(const bf16_t, WS_V) + (size_t)(b * NH + h) * SEQ * VH);
    const int q0 = qb * 256, qrow = q0 + 32 * wid + r, qmin = q0 + 32 * wid;
    bf16x8 qf[12];
#pragma unroll
    for (int ks = 0; ks < 12; ++ks) qf[ks] = *(const bf16x8*)(Qh + (size_t)qrow * QKH + 16 * ks + 8 * hi);
    f32x16 o[4];
#pragma unroll
    for (int d = 0; d < 4; ++d) o[d] = f32x16{};
    float mrun = 0.f, lrun = 0.f; f32x16 negm = f32x16{};
    const int NT = (q0 + 256) / 64;
    unsigned soff[6];
#pragma unroll
    for (int i = 0; i < 6; ++i) { const int p = wid + 8 * i;
        if (p < 25) { const int q = 64 * p + lane, row = q / 25, cc = q % 25; soff[i] = (unsigned)(row * 384 + (cc < 24 ? cc : 23) * 16); }
        else { const int q = 64 * (p - 25) + lane, row = q / 20, cc = q % 20; soff[i] = (unsigned)(row * 256 + (cc < 16 ? cc : 15) * 16); } }
#define ATT_DMA(t, buf) do { const char* kt = Kh + (size_t)(t) * 64 * 384; const char* vt = Vh + (size_t)(t) * 64 * 256; \
        _Pragma("unroll") for (int i = 0; i < 6; ++i) { const int p = wid + 8 * i; if (p < 45) { \
            const char* src = (p < 25) ? kt : vt; const int dst = (p < 25) ? (ATT_KOFF + (buf) * 64 * KST + p * 1024) : (ATT_VOFF + (buf) * 64 * VST + (p - 25) * 1024); \
            unsigned so = soff[i]; asm volatile("" : "+v"(so));     \
            glds16s(src, so, (unsigned)__builtin_amdgcn_readfirstlane((int)(lds0 + dst))); } } } while (0)
    const unsigned lds0 = (unsigned)(uintptr_t)F.lds;
#define ATT_WAIT_BAR() asm volatile("s_waitcnt vmcnt(0) lgkmcnt(0)\n\ts_barrier" ::: "memory")
    ATT_DMA(0, 0); ATT_WAIT_BAR();
#pragma unroll
    for (int ks = 0; ks < 12; ++ks) asm volatile("" : "+v"(qf[ks]));
    const int i16 = lane & 15, q4 = i16 >> 2, p4 = i16 & 3, g2 = (lane >> 4) & 1;
    const int klane = r * KST + 16 * hi, vlane = (4 * hi + q4) * VST + (16 * g2 + 4 * p4) * 2;
    for (int t = 0; t < NT; ++t) {
        const int buf = t & 1;
        if (t + 1 < NT) ATT_DMA(t + 1, buf ^ 1);
        if (64 * t <= qmin + 31) {
            const LAS unsigned char* kb = F.lds + ATT_KOFF + buf * 64 * KST + klane; asm volatile("" : "+v"(kb));
            f32x16 p0 = negm, p1 = negm;
            bf16x8 kf[3][4];
#define ATT_KLOAD(G) do { _Pragma("unroll") for (int j = 0; j < 2; ++j) { kf[(G) % 3][2 * j] = *(const LAS bf16x8*)(kb + 32 * (2 * (G) + j)); kf[(G) % 3][2 * j + 1] = *(const LAS bf16x8*)(kb + 32 * KST + 32 * (2 * (G) + j)); } } while (0)
            ATT_KLOAD(0); ATT_KLOAD(1);
#pragma unroll
            for (int g = 0; g < 6; ++g) {
                if (g + 2 < 6) ATT_KLOAD(g + 2);
#pragma unroll
                for (int j = 0; j < 2; ++j) { p0 = __builtin_amdgcn_mfma_f32_32x32x16_bf16(kf[g % 3][2 * j], qf[2 * g + j], p0, 0, 0, 0); p1 = __builtin_amdgcn_mfma_f32_32x32x16_bf16(kf[g % 3][2 * j + 1], qf[2 * g + j], p1, 0, 0, 0); }
                asm volatile("" : "+v"(kb) : "v"(p0[0]));
            }
#undef ATT_KLOAD
            if (64 * t + 63 > qmin) {
#pragma unroll
                for (int rg = 0; rg < 16; ++rg) { const int key = 64 * t + crow(rg, hi); if (key > qrow) p0[rg] = -INFINITY; if (key + 32 > qrow) p1[rg] = -INFINITY; }
            }
            float mx = 0.f; bool resc = false;
            if (!bounded) {
            const float seed = fmaxf(p0[0], p1[0]);
            float mxa = max3f(seed, p0[1], p1[1]), mxb = max3f(seed, p0[2], p0[3]);
            mxa = max3f(mxa, p1[2], p1[3]);
#pragma unroll
            for (int rg = 4; rg < 16; rg += 2) { mxb = max3f(mxb, p0[rg], p0[rg + 1]); mxa = max3f(mxa, p1[rg], p1[rg + 1]); }
            mx = half_max(fmaxf(mxa, mxb));
            resc = __any(mx > 8.0f);
            }
            float ps = 0.f;
#pragma unroll
            for (int rg = 0; rg < 16; ++rg) { p0[rg] = __builtin_amdgcn_exp2f(p0[rg]); p1[rg] = __builtin_amdgcn_exp2f(p1[rg]); ps += p0[rg]; ps += p1[rg]; }
            lrun += ps;
            bf16x8 pf[4];
#pragma unroll
            for (int s = 0; s < 2; ++s) {
                u32x4 w; w.x = pk2(p0[8 * s], p0[8 * s + 1]); w.y = pk2(p0[8 * s + 2], p0[8 * s + 3]); w.z = pk2(p0[8 * s + 4], p0[8 * s + 5]); w.w = pk2(p0[8 * s + 6], p0[8 * s + 7]); pf[s] = __builtin_bit_cast(bf16x8, w);
                u32x4 w2; w2.x = pk2(p1[8 * s], p1[8 * s + 1]); w2.y = pk2(p1[8 * s + 2], p1[8 * s + 3]); w2.z = pk2(p1[8 * s + 4], p1[8 * s + 5]); w2.w = pk2(p1[8 * s + 6], p1[8 * s + 7]); pf[2 + s] = __builtin_bit_cast(bf16x8, w2); }
            const LAS unsigned char* vb = F.lds + ATT_VOFF + buf * 64 * VST + vlane; asm volatile("" : "+v"(vb));
            s16x4 vl[2][4], vh[2][4];
#pragma unroll
            for (int d = 0; d < 4; ++d) { vl[0][d] = vtr(vb + 64 * d); vh[0][d] = vtr(vb + 8 * VST + 64 * d); }
#pragma unroll
            for (int kk = 0; kk < 4; ++kk) {
                if (kk + 1 < 4) {
#pragma unroll
                    for (int d = 0; d < 4; ++d) { vl[(kk + 1) & 1][d] = vtr(vb + (16 * (kk + 1)) * VST + 64 * d); vh[(kk + 1) & 1][d] = vtr(vb + (16 * (kk + 1) + 8) * VST + 64 * d); } }
#pragma unroll
                for (int d = 0; d < 4; ++d) { const s16x4 lo = vl[kk & 1][d], hh = vh[kk & 1][d];
                    const bf16x8 vf = {lo[0], lo[1], lo[2], lo[3], hh[0], hh[1], hh[2], hh[3]};
                    o[d] = __builtin_amdgcn_mfma_f32_32x32x16_bf16(vf, pf[kk], o[d], 0, 0, 0); }
                asm volatile("" : "+v"(vb) : "v"(o[0][0]));
            }
            if (resc) {
                const float dl = fmaxf(mx, 0.f), alpha = __builtin_amdgcn_exp2f(-dl); mrun += dl; lrun *= alpha;
#pragma unroll
                for (int rg = 0; rg < 16; ++rg) negm[rg] = -mrun;
#pragma unroll
                for (int d = 0; d < 4; ++d)
#pragma unroll
                    for (int rg = 0; rg < 16; ++rg) o[d][rg] *= alpha;
            }
        }
        ATT_WAIT_BAR();
    }
#undef ATT_DMA
#undef ATT_WAIT_BAR
    lrun = half_sum(lrun);
    const float rinv = __builtin_amdgcn_rcpf(lrun);
    bf16_t* orow = WSP(bf16_t, WS_H) + (size_t)(b * SEQ + qrow) * DM + SGU_W + VH * h;
#pragma unroll
    for (int d = 0; d < 4; ++d)
#pragma unroll
        for (int g4 = 0; g4 < 4; ++g4) { u32x2 w; w.x = pk2(o[d][4 * g4] * rinv, o[d][4 * g4 + 1] * rinv); w.y = pk2(o[d][4 * g4 + 2] * rinv, o[d][4 * g4 + 3] * rinv);
            *(u32x2*)(orow + 32 * d + 8 * g4 + 4 * hi) = w; }
}
__device__ __forceinline__ void attn_phase(const Frame& F0, int l) {
    Frame F = phase_frame(F0);
    float gq = 0.f, gk = 0.f;
#pragma unroll
    for (int i = 0; i < 3; ++i) { gq = fmaxf(gq, fabsf(FIN(float, I_QN)[l * QKH + F.lane + 64 * i])); gk = fmaxf(gk, fabsf(FIN(float, I_KN)[l * QKH + F.lane + 64 * i])); }
    gq = wave_max(gq, F.lane); gk = wave_max(gk, F.lane);
    const bool bounded = __builtin_amdgcn_readfirstlane(__builtin_bit_cast(int, gq * gk)) <= __builtin_bit_cast(int, 2.0f);
    for (int pr = F.vcu; pr < NB * NH * 8; pr += F.G) {
        const int bh = pr >> 3, j = pr & 7;
        attn_unit(F, bh >> 2, bh & 3, 15 - j, bounded);
        attn_unit(F, bh >> 2, bh & 3, j, bounded);
    }
}

constexpr int NPHASE = 21;
struct Args { const void* in[25]; float* out; unsigned char* ws; int ph_lo, ph_hi; };
__global__ void __launch_bounds__(NTHR, 2) fwd_kernel(Args args) {
    extern __shared__ __attribute__((aligned(16))) unsigned char lds_raw[];
    Frame F0;
    F0.lds = (LAS unsigned char*)lds_raw;
    F0.tid = threadIdx.x; F0.lane = F0.tid & 63; F0.wave = __builtin_amdgcn_readfirstlane(F0.tid >> 6);
    F0.G = gridDim.x; { const int bx = blockIdx.x; F0.vcu = (F0.G % 8 == 0) ? (bx % 8) * (F0.G / 8) + bx / 8 : bx; }
    F0.out = (GAS float*)args.out; F0.ws = (GAS unsigned char*)args.ws;
    const Frame& F = F0;
    volatile LAS unsigned* MISC = (volatile LAS unsigned*)(F0.lds + MISC_OFF);
    if (F0.tid < 64) MISC[F0.tid] = 0u;
    __syncthreads();
    const int lo = args.ph_lo, hi = args.ph_hi;
    const bool one = (MK_N_LAUNCHES == 1) || (hi - lo) > 1;
    XcdBarrier bar; bar.bar = (unsigned*)(F0.ws + WS_CTL) + CW_BAR; bar.x = 0; bar.st = nullptr; bar.w = F0.wave;
    if (one) bar = xcd_barrier_post((unsigned*)(F0.ws + WS_CTL) + CW_BAR, MISC + 8, F0.wave);
#ifndef PH_MASK
#define PH_MASK 0xFFFFFFFFu
#endif
#define EN(j) (((PH_MASK) >> (j)) & 1u)
#ifndef REPEAT_MASK
#define REPEAT_MASK 0u
#endif
#define NREP(j) ((((REPEAT_MASK) >> (j)) & 1u) ? 2 : 1)
#if MK_N_LAUNCHES == 1
#define IN(k) true
#else
#define IN(k) (lo <= (k) && (k) < hi)
#endif
#define SEAM(k) do { if (IN(k) && IN((k) + 1)) xcd_barrier(bar); } while (0)
    const float* MOD = WSP(const float, WS_MOD);

    if (EN(0) && IN(0)) { for (int rep_ = 0; rep_ < NREP(0); ++rep_) { if (rep_) xcd_barrier(bar);  p0_prologue(F0);  } } SEAM(0);
#pragma unroll 1
    for (int l = 0; l < 2; ++l) {
        const int pb = 1 + 8 * l;
        const float* mod_l = MOD + (size_t)l * NB * (NMOD * DM);
        bf16_t* const XB = WSP(bf16_t, WS_XB);
        if (EN(1) && IN(pb)) { for (int rep_ = 0; rep_ < NREP(1); ++rep_) { if (rep_) xcd_barrier(bar);  if (l == 0) norm_phase<false, true, false>(F0, FIN(float, I_X), FIN(float, I_NMIX), mod_l + 0 * DM, mod_l + 1 * DM, WSP(bf16_t, WS_H), 0); else norm_phase<false, true, true>(F0, XB, FIN(float, I_NMIX) + DM, mod_l + 0 * DM, mod_l + 1 * DM, WSP(bf16_t, WS_H), 0);  } } SEAM(pb);
        if (EN(2) && IN(pb + 1)) { for (int rep_ = 0; rep_ < NREP(2); ++rep_) { if (rep_) xcd_barrier(bar);
            const Frame F = phase_frame(F0); pg8::DenseSched S; S.so.init(NTOK / 256, D_INP / 256, F.G, (int)blockIdx.x); S.A = (const char*)WSP(bf16_t, WS_H); S.Bt = (const char*)(F.ws + WS_WIN) + (size_t)l * D_INP * DM; S.tstep = (size_t)256 * DM;
            EpiInProj E{WSP(bf16_t, WS_U), WSP(bf16_t, WS_GV), WSP(bf16_t, WS_CQ), WSP(bf16_t, WS_CKV), WSP(bf16_t, WS_KR), WSP(const float, WS_SA), WSP(const float, WS_SBIN) + l * D_INP};
            pg8::gemm_phase<EpiInProj, pg8::DenseSched, true, true>(F.lds, F.wave, DM / 2, DM / 2, S, E);
         } } SEAM(pb + 1);
        if (EN(3) && IN(pb + 2)) { for (int rep_ = 0; rep_ < NREP(3); ++rep_) { if (rep_) xcd_barrier(bar);  mid_phase(F0, l);  } } SEAM(pb + 2);
        if (EN(4) && IN(pb + 3)) { for (int rep_ = 0; rep_ < NREP(4); ++rep_) { if (rep_) xcd_barrier(bar);  attn_phase(F0, l);  } } SEAM(pb + 3);
        if (EN(5) && IN(pb + 4)) {
            const Frame F = phase_frame(F0); pg8::DenseSched S; S.so.init(NTOK / 256, DM / 256, F.G, (int)blockIdx.x); S.A = (const char*)WSP(bf16_t, WS_H); S.Bt = (const char*)(WSP(bf16_t, WS_WOUT) + (size_t)l * DM * DM); S.tstep = (size_t)256 * DM * 2;
            if (l == 0) { EpiResidB<true> E{FIN(float, I_X), XB, mod_l + 2 * DM}; pg8::gemm_phase<EpiResidB<true>, pg8::DenseSched, true>(F.lds, F.wave, DM, DM, S, E); }
            else { EpiResidB<false> E{XB, XB, mod_l + 2 * DM}; pg8::gemm_phase<EpiResidB<false>, pg8::DenseSched, true>(F.lds, F.wave, DM, DM, S, E); }
        } SEAM(pb + 4);
        if (l == 0) {
            if (EN(1) && IN(6)) { for (int rep_ = 0; rep_ < NREP(1); ++rep_) { if (rep_) xcd_barrier(bar);  norm_phase<false, true, true>(F0, XB, FIN(float, I_NFFN), mod_l + 3 * DM, mod_l + 4 * DM, WSP(bf16_t, WS_H), 0);  } } SEAM(6);
            if (EN(6) && IN(7)) { for (int rep_ = 0; rep_ < NREP(6); ++rep_) { if (rep_) xcd_barrier(bar);
                const Frame F = phase_frame(F0); pg8::DenseSched S; S.so.init(NTOK / 256, 5632 / 256, F.G, (int)blockIdx.x); S.A = (const char*)WSP(bf16_t, WS_H); S.Bt = (const char*)WSP(bf16_t, WS_WFU); S.tstep = (size_t)256 * DM;
                EpiSwiGLU8 E{WSP(bf16_t, WS_ACT), WSP(const float, WS_SA), WSP(const float, WS_SB), nullptr};
                pg8::gemm_phase<EpiSwiGLU8, pg8::DenseSched, true, true>(F.lds, F.wave, DM / 2, DM / 2, S, E);
             } } SEAM(7);
            if (EN(7) && IN(8)) {
                const Frame F = phase_frame(F0); pg8::DenseSched S; S.so.init(NTOK / 256, DM / 256, F.G, (int)blockIdx.x); S.A = (const char*)WSP(bf16_t, WS_ACT); S.Bt = (const char*)WSP(bf16_t, WS_WFD); S.tstep = (size_t)256 * DFF * 2;
                EpiResidB<false> E{XB, XB, mod_l + 5 * DM};
                pg8::gemm_phase<EpiResidB<false>, pg8::DenseSched, true>(F.lds, F.wave, DFF, DFF, S, E);
            } SEAM(8);
        } else {
            if (EN(8) && IN(14)) { for (int rep_ = 0; rep_ < NREP(8); ++rep_) { if (rep_) xcd_barrier(bar);  norm_phase<true, true, true>(F0, XB, FIN(float, I_NFFN) + DM, mod_l + 3 * DM, mod_l + 4 * DM, WSP(bf16_t, WS_H), 0);  } } SEAM(14);
            if (EN(9) && IN(15)) { for (int rep_ = 0; rep_ < NREP(9); ++rep_) { if (rep_) xcd_barrier(bar);  route_phase(F0);  } } SEAM(15);
#pragma unroll 1
            for (int s = 0; s < 2; ++s) {
                if (EN(10) && IN(16 + 2 * s)) { for (int rep_ = 0; rep_ < NREP(10); ++rep_) { if (rep_) xcd_barrier(bar);
                    if (s == 1 && rep_ == 0) moe_tail_reduce<false>(F0, 0, mod_l + 5 * DM);
                    const Frame F = phase_frame(F0); const int n = moe_prep(F, s, 0);
                    pg8::MoeSched<true> S; S.ul = (const LAS int*)(F.lds + LDS_UL_OFF); S.idx = (const LAS int*)(F.lds + LDS_IDX_OFF); S.n = n; S.aux0 = 0; S.A = (const char*)WSP(bf16_t, WS_H); S.Bt = (const char*)WSP(bf16_t, WS_WMU);
                    S.tstepA = 0; S.tstepB = (size_t)256 * DM; S.estride = (size_t)5632 * DM;
                    EpiSwiGLU8 E{WSP(bf16_t, WS_ACT), WSP(const float, WS_RSA) + s * SLOTROWS, WSP(const float, WS_SB) + 5632, nullptr};
                    pg8::gemm_phase<EpiSwiGLU8, pg8::MoeSched<true>, true, true>(F.lds, F.wave, DM / 2, DM / 2, S, E);
                 } } SEAM(16 + 2 * s);
                if (EN(11) && IN(17 + 2 * s)) {
                    const Frame F = phase_frame(F0); const int n = moe_prep(F, s, 1); const int nt2 = moe_prep(F, s, 2);
                    {
                        pg8::MoeSched<false> S; S.ul = (const LAS int*)(F.lds + LDS_UL_OFF); S.idx = nullptr; S.n = n; S.aux0 = 0; S.A = (const char*)WSP(bf16_t, WS_ACT); S.Bt = (const char*)WSP(bf16_t, WS_WMD);
                        S.tstepA = (size_t)256 * DFF * 2; S.tstepB = (size_t)256 * DFF * 2; S.estride = (size_t)DM * DFF * 2;
                        if (s == 0) { EpiMoeDownB<false> E{XB, (float*)F.out, mod_l + 5 * DM, WSP(const int, WS_RMAP), WSP(const float, WS_RGATE)}; pg8::gemm_phase<EpiMoeDownB<false>, pg8::MoeSched<false>, true>(F.lds, F.wave, DFF, DFF, S, E); }
                        else { EpiMoeDownB<true> E{XB, (float*)F.out, mod_l + 5 * DM, WSP(const int, WS_RMAP) + SLOTROWS, WSP(const float, WS_RGATE) + SLOTROWS}; pg8::gemm_phase<EpiMoeDownB<true>, pg8::MoeSched<false>, true>(F.lds, F.wave, DFF, DFF, S, E); }
                    }
                    {
                        pg8::MoeSched<false> S; S.ul = (const LAS int*)(F.lds + LDS_UL_OFF + 256); S.idx = nullptr; S.n = nt2; S.aux0 = 0; S.A = (const char*)WSP(bf16_t, WS_ACT); S.Bt = (const char*)WSP(bf16_t, WS_WMD);
                        S.tstepA = (size_t)256 * DFF * 2; S.tstepB = (size_t)256 * DFF * 2; S.estride = (size_t)DM * DFF * 2;
                        EpiPartial E{(unsigned char*)F.ws};
                        pg8::gemm_phase<EpiPartial, pg8::MoeSched<false>, true>(F.lds, F.wave, 256, DFF, S, E);
                    }
                } SEAM(17 + 2 * s);
            }
            if (EN(11) && IN(20)) { moe_tail_reduce<true>(F0, 1, mod_l + 5 * DM); }
        }
    }
#undef IN
#undef SEAM
}

extern "C" void kernel_launch(void* const* d_in, const int* in_sizes, int n_in, void* d_out, int out_size, void* d_ws, size_t ws_size, hipStream_t stream) {
    static int grid = 0;
    if (grid == 0) {
        if (n_in != 25 || out_size != NTOK * DM || ws_size < WS_END) { fprintf(stderr, "kernel_launch: unexpected shapes (n_in %d, out %d, ws %zu)\n", n_in, out_size, ws_size); grid = -1; return; }
        int dev = 0, cus = 0, per_cu = 0;
        if (hipGetDevice(&dev) != hipSuccess || hipDeviceGetAttribute(&cus, hipDeviceAttributeMultiprocessorCount, dev) != hipSuccess) { grid = -1; return; }
        if (hipFuncSetAttribute((const void*)fwd_kernel, hipFuncAttributeMaxDynamicSharedMemorySize, LDS_BYTES) != hipSuccess) { fprintf(stderr, "kernel_launch: hipFuncSetAttribute failed\n"); grid = -1; return; }
        if (hipOccupancyMaxActiveBlocksPerMultiprocessor(&per_cu, (const void*)fwd_kernel, NTHR, LDS_BYTES) != hipSuccess || per_cu < 1) fprintf(stderr, "kernel_launch: occupancy query reports %d\n", per_cu);
        (void)hipGetLastError();
        grid = cus;
    }
    if (grid < 0) return;
    if (hipMemsetAsync((char*)d_ws + WS_CTL, 0, CTL_ZERO_BYTES, stream) != hipSuccess) return;
    Args a{};
    for (int i = 0; i < 25; ++i) a.in[i] = d_in[i];
    a.out = (float*)d_out; a.ws = (unsigned char*)d_ws;
#if MK_N_LAUNCHES == 1
    a.ph_lo = 0; a.ph_hi = NPHASE;
    hipLaunchKernelGGL(fwd_kernel, dim3(grid), dim3(NTHR), LDS_BYTES, stream, a);
#else
    for (int k = 0; k < NPHASE; ++k) { a.ph_lo = k; a.ph_hi = k + 1; hipLaunchKernelGGL(fwd_kernel, dim3(grid), dim3(NTHR), LDS_BYTES, stream, a); }
#endif
}
```

```cpp
#include <hip/hip_runtime.h>
#include <cstdio>
#include <cstdint>

#define REPEAT_MASK 0x0u
#ifndef MK_N_LAUNCHES
#define MK_N_LAUNCHES 1
#endif

#define GAS __attribute__((address_space(1)))
#define LAS __attribute__((address_space(3)))
typedef unsigned short bf16_t;
typedef short bf16x8 __attribute__((ext_vector_type(8)));
typedef short s16x4 __attribute__((ext_vector_type(4)));
typedef float f32x4 __attribute__((ext_vector_type(4)));
typedef float f32x2 __attribute__((ext_vector_type(2)));
typedef float f32x16 __attribute__((ext_vector_type(16)));
typedef unsigned u32x4 __attribute__((ext_vector_type(4)));
typedef unsigned u32x2 __attribute__((ext_vector_type(2)));
typedef int i32x4 __attribute__((ext_vector_type(4)));
typedef GAS unsigned gu32;
#define RLX_AGENT __ATOMIC_RELAXED, __HIP_MEMORY_SCOPE_AGENT
#define LDS_WAIT() asm volatile("s_waitcnt lgkmcnt(0)" ::: "memory")
#define VM_WAIT() asm volatile("s_waitcnt vmcnt(0)" ::: "memory")

constexpr int DM = 1024, NB = 8, SEQ = 4096, NTOK = NB * SEQ;
constexpr int SGU_W = 512, NGRP = 8, GDIM = 64, CHUNK = 128;
constexpr int NH = 4, QKN = 128, QKR = 64, QKH = 192, VH = 128;
constexpr int QLORA = 256, KVLORA = 128, D_IN = 1472, D_INP = 1536;
constexpr int DFF = 2816, NEXP = 8, NMOD = 6;
constexpr float EPS = 1e-6f;
constexpr int NWAVES = 8, NTHR = 512;
constexpr int MAXTILES = 135;
constexpr int SLOTROWS = MAXTILES * 256;

constexpr size_t MiB = 1u << 20;
constexpr size_t WS_CTL = 0, CTL_ZERO_BYTES = 1 * MiB;
constexpr size_t WS_MOD = 1 * MiB;
constexpr size_t WS_COS = 2 * MiB, WS_SIN = 6 * MiB;
constexpr size_t WS_RTE = 10 * MiB;
constexpr size_t WS_RTW = WS_RTE + 128 * 1024;
constexpr size_t WS_CNT = WS_RTW + 256 * 1024;
constexpr size_t WS_RMAP = WS_CNT + 16 * 1024;
constexpr size_t WS_RGATE = WS_RMAP + 288 * 1024;
constexpr size_t WS_TAB = WS_RGATE + 288 * 1024;
static_assert(2 * SLOTROWS * 4 <= 288 * 1024 && WS_TAB + 4096 <= 11 * MiB, "route tables");
constexpr size_t WS_SB = 11 * MiB;
constexpr size_t WS_SBIN = 11 * MiB + 224 * 1024;
constexpr size_t WS_RSA = 11 * MiB + 384 * 1024;
constexpr size_t WS_SA = 11 * MiB + 256 * 1024;
constexpr size_t CTL_AMAX = 256 * 1024;
static_assert(WS_RSA + 2 * SLOTROWS * 4 <= 12 * MiB && WS_SB + 9 * 5632 * 4 <= WS_SBIN && WS_SBIN + 2 * 1536 * 4 <= WS_SA && WS_SA + NTOK * 4 <= 12 * MiB && CTL_AMAX + 18 * 2816 * 4 <= CTL_ZERO_BYTES, "int8 tables");
constexpr size_t WS_WIN = 12 * MiB;
constexpr size_t WS_WUQ = 18 * MiB;
constexpr size_t WS_WUKV = 19 * MiB;
constexpr size_t WS_SGUW = 19 * MiB + 512 * 1024;
constexpr size_t WS_WOUT = 20 * MiB;
constexpr size_t WS_WFU = 24 * MiB;
constexpr size_t WS_WFD = 35 * MiB;
constexpr size_t WS_WMU = 41 * MiB;
constexpr size_t WS_WMD = 85 * MiB;
constexpr size_t WS_XB = 129 * MiB;
constexpr size_t WS_H = 193 * MiB;
constexpr size_t WS_BIG = 257 * MiB;
constexpr size_t WS_ACT = WS_BIG;
constexpr size_t WS_U = WS_BIG, WS_GV = WS_BIG + 32 * MiB, WS_CQ = WS_BIG + 64 * MiB, WS_CKV = WS_BIG + 80 * MiB, WS_KR = WS_BIG + 88 * MiB;
constexpr size_t WS_Q = WS_BIG + 92 * MiB, WS_K = WS_BIG + 140 * MiB, WS_V = WS_BIG + 188 * MiB, WS_END = WS_BIG + 220 * MiB;
static_assert(WS_ACT + (size_t)SLOTROWS * DFF * 2 <= WS_END && WS_END <= 512 * MiB, "d_ws map");
static_assert(WS_WMU + (size_t)8 * 5632 * 1024 <= WS_WMD && WS_WMD + (size_t)8 * 1024 * 2816 * 2 <= WS_XB && WS_XB + (size_t)NTOK * DM * 2 <= WS_H && WS_H + (size_t)NTOK * DM * 2 <= WS_BIG, "weights map");
constexpr int CW_BAR = 4096;

constexpr int RING_BYTES = 131072;
constexpr int LDS_TAB_OFF = 139264;
constexpr int LDS_UL_OFF = LDS_TAB_OFF, LDS_IDX_OFF = LDS_TAB_OFF + 512;
constexpr int LDS_BYTES = 163840;
constexpr int MISC_OFF = LDS_BYTES - 256;
static_assert(LDS_IDX_OFF + 12 * 1024 <= MISC_OFF, "LDS tables");
static_assert(LDS_BYTES <= 163840, "LDS");

__device__ __forceinline__ unsigned f2bf(float f) { unsigned u = __builtin_bit_cast(unsigned, f); return (u + 0x7fffu + ((u >> 16) & 1u)) >> 16; }
typedef __bf16 bf16x2_t __attribute__((ext_vector_type(2)));
__device__ __forceinline__ unsigned pk2(float lo, float hi) { const f32x2 v = {lo, hi}; const bf16x2_t b = __builtin_convertvector(v, bf16x2_t); return __builtin_bit_cast(unsigned, b); }
__device__ __forceinline__ float bflo(unsigned w) { return __builtin_bit_cast(float, w << 16); }
__device__ __forceinline__ float bfhi(unsigned w) { return __builtin_bit_cast(float, w & 0xffff0000u); }
__device__ __forceinline__ float bf1(bf16_t h) { return __builtin_bit_cast(float, ((unsigned)h) << 16); }
__device__ __forceinline__ int crow(int r, int hi) { return (r & 3) + 8 * (r >> 2) + 4 * hi; }
__device__ __forceinline__ int lane_id() { int l; asm volatile("v_mbcnt_lo_u32_b32 %0, -1, 0\n\tv_mbcnt_hi_u32_b32 %0, -1, %0" : "=v"(l)); return l; }
__device__ __forceinline__ float wave_sum(float v, int lane) {
#pragma unroll
    for (int o = 1; o < 64; o <<= 1) v += __builtin_bit_cast(float, __builtin_amdgcn_ds_bpermute((lane ^ o) << 2, __builtin_bit_cast(int, v)));
    return v;
}
__device__ __forceinline__ float wave_max(float v, int lane) {
#pragma unroll
    for (int o = 1; o < 64; o <<= 1) v = fmaxf(v, __builtin_bit_cast(float, __builtin_amdgcn_ds_bpermute((lane ^ o) << 2, __builtin_bit_cast(int, v))));
    return v;
}
__device__ __forceinline__ unsigned pack_i8x4(float a, float b, float c, float d) {
    const int ia = (int)__builtin_rintf(a), ib = (int)__builtin_rintf(b), ic = (int)__builtin_rintf(c), id = (int)__builtin_rintf(d);
    return (unsigned)(ia & 255) | ((unsigned)(ib & 255) << 8) | ((unsigned)(ic & 255) << 16) | ((unsigned)id << 24);
}
__device__ __forceinline__ float half_sum(float v) {
    auto rr = __builtin_amdgcn_permlane32_swap(__builtin_bit_cast(unsigned, v), __builtin_bit_cast(unsigned, v), false, false);
    return __builtin_bit_cast(float, (unsigned)rr[0]) + __builtin_bit_cast(float, (unsigned)rr[1]);
}
__device__ __forceinline__ float half_max(float v) {
    auto rr = __builtin_amdgcn_permlane32_swap(__builtin_bit_cast(unsigned, v), __builtin_bit_cast(unsigned, v), false, false);
    return fmaxf(__builtin_bit_cast(float, (unsigned)rr[0]), __builtin_bit_cast(float, (unsigned)rr[1]));
}
__device__ __forceinline__ unsigned ld_agent(const unsigned* p) { return __hip_atomic_load(p, RLX_AGENT); }
__device__ __forceinline__ s16x4 vtr(const LAS unsigned char* p) { typedef short v4i16_t __attribute__((ext_vector_type(4))); return __builtin_bit_cast(s16x4, __builtin_amdgcn_ds_read_tr16_b64_v4i16((LAS v4i16_t*)p)); }

namespace pg8 {
constexpr int BM = 256, BK = 64, HALF = 128, HTB = HALF * BK * 2, STAGE_BYTES = 8 * HTB, NXCD = 8, WGM = 4;
__host__ __device__ __forceinline__ int lds_byte(int r, int c) { const int st = (r >> 4) * 2 + (c >> 5), rr = r & 15, cc = c & 31, ob = rr * 64 + cc * 2; return st * 1024 + (ob ^ (((ob >> 9) & 1) << 5)); }
__host__ __device__ __forceinline__ void stage_rc(int b, int& R, int& C) { const int st = b / 1024, sb = b % 1024, swz = sb ^ (((sb >> 9) & 1) << 5); R = (st >> 1) * 16 + swz / 64; C = (st & 1) * 32 + (swz % 64) / 2; }
__host__ __device__ __forceinline__ int perm32(int rho) { const int n = rho >> 4, i = rho & 15; return 8 * (i >> 2) + 4 * n + (i & 3); }

struct Unit { int pm, pn; const char* a; const char* b; int aux; };

struct StaticOrder {
    int nM, nN, nwg, G, c;
    __device__ void init(int nM_, int nN_, int G_, int c_) { nM = nM_; nN = nN_; nwg = nM * nN; G = G_; c = c_; }
    __device__ bool tile(int i, int& pm, int& pn) const {
        const long L = (long)i * G + c; if (L >= nwg) return false;
        int wgid = (int)L; { const int q = nwg / NXCD, r = nwg % NXCD, xcd = wgid % NXCD, off = wgid / NXCD; wgid = (xcd < r ? xcd * (q + 1) : r * (q + 1) + (xcd - r) * q) + off; }
        const int nig = WGM * nN, gid = wgid / nig, fm = gid * WGM, gsz = (nM - fm) < WGM ? (nM - fm) : WGM;
        pm = fm + ((wgid % nig) % gsz); pn = (wgid % nig) / gsz; return true;
    }
};
struct DenseSched {
    static constexpr bool GATHER = false;
    StaticOrder so; const char* A; const char* Bt; size_t tstep;
    __device__ bool next(int i, Unit& u) const { if (!so.tile(i, u.pm, u.pn)) return false; u.aux = 0; u.a = A + (size_t)u.pm * tstep; u.b = Bt + (size_t)u.pn * tstep; return true; }
    __device__ __forceinline__ void rows(int, const int (&R)[2], const int (&C)[2], int K, unsigned (&v)[2][2]) const {
#pragma unroll
        for (int h = 0; h < 2; ++h)
#pragma unroll
            for (int i = 0; i < 2; ++i) v[h][i] = (unsigned)((h * HALF + R[i]) * K + C[i]) * 2u;
    }
};
template <bool GATHER_> struct MoeSched {
    static constexpr bool GATHER = GATHER_;
    const LAS int* ul; const LAS int* idx; int n, aux0; const char* A; const char* Bt; size_t tstepA, tstepB, estride;
    __device__ bool next(int i, Unit& u) const { if (i >= n) return false; u.pm = ul[4 * i]; u.pn = ul[4 * i + 1]; const int e = ul[4 * i + 2]; u.aux = ul[4 * i + 3] | (e << 8);
        const size_t ko = (size_t)ul[4 * i + 3] * 512;
        u.a = GATHER ? A : A + (size_t)u.pm * tstepA + ko; u.b = Bt + (size_t)e * estride + (size_t)u.pn * tstepB + ko; return true; }
    __device__ __forceinline__ void rows(int ui, const int (&R)[2], const int (&C)[2], int K, unsigned (&v)[2][2]) const {
#pragma unroll
        for (int h = 0; h < 2; ++h)
#pragma unroll
            for (int i = 0; i < 2; ++i) { const int row = GATHER ? idx[ui * 256 + h * HALF + R[i]] : (h * HALF + R[i]); v[h][i] = (unsigned)(row * K + C[i]) * 2u; }
    }
};

template <class Epi, class Sched, bool ALIGN_EPI, bool I8 = false>
__device__ __forceinline__ void gemm_phase(LAS unsigned char* lds, const int wave, const int K, const int ldk, const Sched& S, const Epi& E) {
    int lane = lane_id(); asm volatile("" : "+v"(lane));
    const int wid = wave, tid = wave * 64 + lane, wr = wid >> 2, wc = wid & 3, fr = lane & 15, fq = lane >> 4;
    const int nt = K / BK;
    int Rr[2], Cc[2]; unsigned voffB[2];
#pragma unroll
    for (int i = 0; i < 2; ++i) { stage_rc(tid * 16 + i * 8192, Rr[i], Cc[i]); const int Rb = Epi::PERM ? ((Rr[i] & ~31) + perm32(Rr[i] & 31)) : Rr[i]; voffB[i] = (unsigned)(Rb * ldk + Cc[i]) * 2u; }
    const size_t kstep = (size_t)(BK * 2);
    const size_t hstep = (size_t)HALF * ldk * 2;
    const unsigned ldsw = (unsigned)wid * 1024u;
    const int aoff = lds_byte(wr * 64 + fr, fq * 8), boff = lds_byte(wc * 32 + fr, fq * 8);
#define PG8_SA(b, h) (((b) * 2 + (h)) * HTB)
#define PG8_SB(b, h) ((4 + (b) * 2 + (h)) * HTB)
#define PG8_STAGE_B(bufoff, gbase) do { _Pragma("unroll") for (int _i = 0; _i < 2; ++_i) \
        __builtin_amdgcn_global_load_lds((const unsigned*)((const char*)(gbase) + voffB[_i]), (LAS unsigned*)(lds + (bufoff) + ldsw + _i * 8192), 16, 0, 0); } while (0)
#define PG8_STAGE_A(bufoff, gbase, V, h) do { _Pragma("unroll") for (int _i = 0; _i < 2; ++_i) \
        __builtin_amdgcn_global_load_lds((const unsigned*)((const char*)(gbase) + (V)[h][_i]), (LAS unsigned*)(lds + (bufoff) + ldsw + _i * 8192), 16, 0, 0); } while (0)
#define PG8_LDA(dst, b, h) do { _Pragma("unroll") for (int m = 0; m < 4; ++m) _Pragma("unroll") for (int k = 0; k < 2; ++k) dst[m][k] = *(const LAS bf16x8*)(lds + PG8_SA(b, h) + aoff + m * 2048 + k * 1024); } while (0)
#define PG8_LDB(dst, b, h) do { _Pragma("unroll") for (int n = 0; n < 2; ++n) _Pragma("unroll") for (int k = 0; k < 2; ++k) dst[n][k] = *(const LAS bf16x8*)(lds + PG8_SB(b, h) + boff + n * 2048 + k * 1024); } while (0)
#define PG8_MMA(ai, bj, At, Bt) do { __builtin_amdgcn_s_setprio(1); _Pragma("unroll") for (int m = 0; m < 4; ++m) _Pragma("unroll") for (int n = 0; n < 2; ++n) _Pragma("unroll") for (int k = 0; k < 2; ++k) { \
        if constexpr (I8) acc[ai][bj][m][n] = __builtin_bit_cast(f32x4, __builtin_amdgcn_mfma_i32_16x16x64_i8(__builtin_bit_cast(i32x4, Bt[n][k]), __builtin_bit_cast(i32x4, At[m][k]), __builtin_bit_cast(i32x4, acc[ai][bj][m][n]), 0, 0, 0)); \
        else acc[ai][bj][m][n] = __builtin_amdgcn_mfma_f32_16x16x32_bf16(Bt[n][k], At[m][k], acc[ai][bj][m][n], 0, 0, 0); } __builtin_amdgcn_s_setprio(0); } while (0)
#define PG8_WAIT_V(n) asm volatile("s_waitcnt vmcnt(" #n ")" ::: "memory")
#define PG8_WAIT_L(n) asm volatile("s_waitcnt lgkmcnt(" #n ")" ::: "memory")
#define PG8_BAR __builtin_amdgcn_s_barrier()
#define PG8_SCHED __builtin_amdgcn_sched_barrier(0)
    Unit cur, nxt; int ui = 0;
    if (!S.next(0, cur)) return;
    unsigned vA[2][2], vN[2][2];
    S.rows(0, Rr, Cc, ldk, vA);
#pragma unroll
    for (int h = 0; h < 2; ++h)
#pragma unroll
        for (int i = 0; i < 2; ++i) vN[h][i] = vA[h][i];
    f32x4 acc[2][2][4][2];
#pragma unroll
    for (int a = 0; a < 2; ++a)
#pragma unroll
        for (int b = 0; b < 2; ++b)
#pragma unroll
            for (int m = 0; m < 4; ++m)
#pragma unroll
                for (int n = 0; n < 2; ++n) acc[a][b][m][n] = (f32x4){0.f, 0.f, 0.f, 0.f};
    bf16x8 At[4][2], B0[2][2], B1[2][2];
    const char* cA = cur.a; const char* cB = cur.b;
    PG8_STAGE_B(PG8_SB(0, 0), cB); PG8_STAGE_B(PG8_SB(0, 1), cB + hstep); PG8_STAGE_A(PG8_SA(0, 0), cA, vA, 0); PG8_STAGE_A(PG8_SA(0, 1), cA, vA, 1);
    if (wr == 1) PG8_BAR;
    PG8_WAIT_V(2); PG8_BAR;
    PG8_STAGE_B(PG8_SB(1, 0), cB + kstep); PG8_STAGE_A(PG8_SA(1, 0), cA + kstep, vA, 0); PG8_STAGE_B(PG8_SB(1, 1), cB + hstep + kstep);
    PG8_WAIT_V(6); PG8_BAR;
    for (;;) {
        const bool has_next = S.next(ui + 1, nxt);
        const char* nA = has_next ? nxt.a : cA; const char* nB = has_next ? nxt.b : cB;
        for (int t = 0; t < nt; t += 2) {
            const bool last = (t == nt - 2);
            const char* a1 = cA + (size_t)(t + 1) * kstep;
            const char* a2 = last ? nA : cA + (size_t)(t + 2) * kstep; const char* b2 = last ? nB : cB + (size_t)(t + 2) * kstep;
            const char* a3 = a2 + kstep; const char* b3 = b2 + kstep;
            unsigned v2[2][2];
            if constexpr (Sched::GATHER) {
                if (last && has_next) S.rows(ui + 1, Rr, Cc, ldk, vN);
#pragma unroll
                for (int h = 0; h < 2; ++h)
#pragma unroll
                    for (int i = 0; i < 2; ++i) v2[h][i] = last ? vN[h][i] : vA[h][i];
            } else {
#pragma unroll
                for (int h = 0; h < 2; ++h)
#pragma unroll
                    for (int i = 0; i < 2; ++i) v2[h][i] = vA[h][i];
            }
            PG8_LDB(B0, 0, 0); PG8_LDB(B1, 0, 1); PG8_SCHED; PG8_LDA(At, 0, 0); PG8_STAGE_A(PG8_SA(1, 1), a1, vA, 1);
            PG8_WAIT_V(8); PG8_WAIT_L(0); PG8_BAR; PG8_MMA(0, 0, At, B0); PG8_MMA(0, 1, At, B1); PG8_BAR; PG8_SCHED;
            PG8_LDA(At, 0, 1); PG8_STAGE_B(PG8_SB(0, 0), b2); PG8_STAGE_B(PG8_SB(0, 1), b2 + hstep); PG8_STAGE_A(PG8_SA(0, 0), a2, v2, 0);
            PG8_WAIT_V(8); PG8_WAIT_L(0); PG8_BAR; PG8_MMA(1, 0, At, B0); PG8_MMA(1, 1, At, B1); PG8_BAR; PG8_SCHED;
            PG8_LDB(B0, 1, 0); PG8_LDB(B1, 1, 1); PG8_SCHED; PG8_LDA(At, 1, 0); PG8_STAGE_A(PG8_SA(0, 1), a2, v2, 1);
            PG8_WAIT_V(8); PG8_WAIT_L(0); PG8_BAR; PG8_MMA(0, 0, At, B0); PG8_MMA(0, 1, At, B1); PG8_BAR; PG8_SCHED;
            PG8_LDA(At, 1, 1); PG8_STAGE_B(PG8_SB(1, 0), b3); PG8_STAGE_B(PG8_SB(1, 1), b3 + hstep); PG8_STAGE_A(PG8_SA(1, 0), a3, v2, 0);
            PG8_WAIT_V(8); PG8_WAIT_L(0); PG8_BAR; PG8_MMA(1, 0, At, B0); PG8_MMA(1, 1, At, B1); PG8_BAR; PG8_SCHED;
        }
        if constexpr (ALIGN_EPI) { if (wr == 0) PG8_BAR; }
        E(acc, cur, wr, wc, fr, fq);
        if (!has_next) break;
#pragma unroll
        for (int a = 0; a < 2; ++a)
#pragma unroll
            for (int b = 0; b < 2; ++b)
#pragma unroll
                for (int m = 0; m < 4; ++m)
#pragma unroll
                    for (int n = 0; n < 2; ++n) acc[a][b][m][n] = (f32x4){0.f, 0.f, 0.f, 0.f};
        cur = nxt; cA = nA; cB = nB; ++ui;
#pragma unroll
        for (int h = 0; h < 2; ++h)
#pragma unroll
            for (int i = 0; i < 2; ++i) vA[h][i] = vN[h][i];
        if constexpr (ALIGN_EPI) { if (wr == 1) PG8_BAR; }
    }
    PG8_WAIT_V(0);
    if constexpr (!ALIGN_EPI) { if (wr == 0) PG8_BAR; }
    PG8_BAR;
#undef PG8_SA
#undef PG8_SB
#undef PG8_STAGE_A
#undef PG8_STAGE_B
#undef PG8_LDA
#undef PG8_LDB
#undef PG8_MMA
#undef PG8_WAIT_V
#undef PG8_WAIT_L
#undef PG8_BAR
#undef PG8_SCHED
}
}

__device__ __forceinline__ float gelu_tanh(float x) {
    const float t = x * (1.0f + 0.044715f * x * x) * 2.3022082f;
    return x * __builtin_amdgcn_rcpf(1.0f + __builtin_amdgcn_exp2f(-t));
}
__device__ __forceinline__ float silu_f(float x) { return x * __builtin_amdgcn_rcpf(1.0f + __builtin_amdgcn_exp2f(-1.4426950408889634f * x)); }

struct EpiInProj {
    static constexpr bool PERM = true;
    bf16_t *U, *GV, *CQ, *CKV, *KR; const float* sa; const float* sb;
    template <int KIND> __device__ __forceinline__ void body(const f32x4 (&acc)[2][2][4][2], int pn, int row0, const float (&srow)[8], int wc, int fq) const {
#pragma unroll
        for (int bj = 0; bj < 2; ++bj) {
            if (KIND == 3 && bj == 1 && wc >= 2) continue;
            const float* sbp = sb + pn * 256 + bj * 128 + wc * 32 + 8 * fq; const f32x4 sc0 = *(const f32x4*)sbp, sc1 = *(const f32x4*)(sbp + 4);
#pragma unroll
            for (int ai = 0; ai < 2; ++ai)
#pragma unroll
                for (int m = 0; m < 4; ++m) {
                    const int row = row0 + ai * 128 + m * 16; const int blk = row >> 5, tok = row & 31; const float sr = srow[ai * 4 + m];
                    const i32x4 i0 = __builtin_bit_cast(i32x4, acc[ai][bj][m][0]), i1 = __builtin_bit_cast(i32x4, acc[ai][bj][m][1]); float v[8];
#pragma unroll
                    for (int j = 0; j < 4; ++j) { v[j] = (float)i0[j] * (sr * sc0[j]); v[4 + j] = (float)i1[j] * (sr * sc1[j]); }
                    if constexpr (KIND < 2) {
                        float t[8];
#pragma unroll
                        for (int j = 0; j < 8; ++j) t[j] = v[j] * v[j];
#pragma unroll
                        for (int j = 0; j < 8; ++j) t[j] = t[j] * -0.10294324f + -2.3022082f;
#pragma unroll
                        for (int j = 0; j < 8; ++j) t[j] = __builtin_amdgcn_exp2f(t[j] * v[j]);
#pragma unroll
                        for (int j = 0; j < 8; ++j) t[j] = t[j] + 1.0f;
#pragma unroll
                        for (int j = 0; j < 8; ++j) t[j] = __builtin_amdgcn_rcpf(t[j]);
#pragma unroll
                        for (int j = 0; j < 8; ++j) v[j] = v[j] * t[j];
                    }
                    u32x4 w; w.x = pk2(v[0], v[1]); w.y = pk2(v[2], v[3]); w.z = pk2(v[4], v[5]); w.w = pk2(v[6], v[7]);
                    if constexpr (KIND == 0) *(u32x4*)(U + (size_t)row * 512 + pn * 256 + bj * 128 + wc * 32 + 8 * fq) = w;
                    else if constexpr (KIND == 1) *(u32x4*)(GV + (size_t)row * 512 + (pn - 2) * 256 + bj * 128 + wc * 32 + 8 * fq) = w;
                    else if constexpr (KIND == 2) *(u32x4*)(CQ + ((size_t)(blk * 32 + 16 * bj + 4 * wc + fq) * 32 + tok) * 8) = w;
                    else if (bj == 0) *(u32x4*)(CKV + ((size_t)(blk * 16 + 4 * wc + fq) * 32 + tok) * 8) = w;
                    else { u32x2 a; a.x = w.x; a.y = w.y; u32x2 b; b.x = w.z; b.y = w.w; const size_t o = ((size_t)(blk * 16 + 8 * wc + 2 * fq) * 32 + tok) * 4; *(u32x2*)(KR + o) = a; *(u32x2*)(KR + o + 128) = b; }
                }
        }
    }
    __device__ __forceinline__ void operator()(const f32x4 (&acc)[2][2][4][2], const pg8::Unit& u, int wr, int wc, int fr, int fq) const {
        const int row0 = u.pm * 256 + wr * 64 + fr; const int pn = u.pn;
        float srow[8];
#pragma unroll
        for (int q = 0; q < 8; ++q) srow[q] = sa[row0 + (q >> 2) * 128 + (q & 3) * 16];
        asm volatile("" : "+v"(srow[0]), "+v"(srow[1]), "+v"(srow[2]), "+v"(srow[3]), "+v"(srow[4]), "+v"(srow[5]), "+v"(srow[6]), "+v"(srow[7]));
        if (pn < 2) body<0>(acc, pn, row0, srow, wc, fq);
        else if (pn < 4) body<1>(acc, pn, row0, srow, wc, fq);
        else if (pn == 4) body<2>(acc, pn, row0, srow, wc, fq);
        else body<3>(acc, pn, row0, srow, wc, fq);
    }
};
__device__ __forceinline__ u32x4 pack8(const f32x4& a, const f32x4& b) { u32x4 w; w.x = pk2(a[0], a[1]); w.y = pk2(a[2], a[3]); w.z = pk2(b[0], b[1]); w.w = pk2(b[2], b[3]); return w; }
__device__ __forceinline__ f32x4 bf4lo(const u32x4& w) { return (f32x4){bflo(w.x), bfhi(w.x), bflo(w.y), bfhi(w.y)}; }
__device__ __forceinline__ f32x4 bf4hi(const u32x4& w) { return (f32x4){bflo(w.z), bfhi(w.z), bflo(w.w), bfhi(w.w)}; }
template <bool BASE_F32> struct EpiResidB {
    static constexpr bool PERM = true;
    const void* base; bf16_t* out; const float* gate;
    __device__ __forceinline__ void operator()(const f32x4 (&acc)[2][2][4][2], const pg8::Unit& u, int wr, int wc, int fr, int fq) const {
        const int row0 = u.pm * 256 + wr * 64 + fr, col0 = u.pn * 256 + wc * 32 + 8 * fq; const int b = u.pm >> 4;
        f32x4 gv[2][2];
#pragma unroll
        for (int bj = 0; bj < 2; ++bj)
#pragma unroll
            for (int n = 0; n < 2; ++n) gv[bj][n] = *(const f32x4*)(gate + (size_t)b * (NMOD * DM) + col0 + bj * 128 + 4 * n);
        if constexpr (BASE_F32) {
#pragma unroll
            for (int ai = 0; ai < 2; ++ai) {
                f32x4 bs[4][2][2];
#pragma unroll
                for (int m = 0; m < 4; ++m)
#pragma unroll
                    for (int bj = 0; bj < 2; ++bj)
#pragma unroll
                        for (int n = 0; n < 2; ++n) bs[m][bj][n] = __builtin_nontemporal_load((const f32x4*)((const float*)base + (size_t)(row0 + ai * 128 + m * 16) * DM + col0 + bj * 128 + 4 * n));
#pragma unroll
                for (int m = 0; m < 4; ++m)
#pragma unroll
                    for (int bj = 0; bj < 2; ++bj)
                        *(u32x4*)(out + (size_t)(row0 + ai * 128 + m * 16) * DM + col0 + bj * 128) = pack8(bs[m][bj][0] + gv[bj][0] * acc[ai][bj][m][0], bs[m][bj][1] + gv[bj][1] * acc[ai][bj][m][1]);
                asm volatile("" ::: "memory");
            }
        } else {
            u32x4 bs[2][4][2];
#pragma unroll
            for (int ai = 0; ai < 2; ++ai)
#pragma unroll
                for (int m = 0; m < 4; ++m)
#pragma unroll
                    for (int bj = 0; bj < 2; ++bj) bs[ai][m][bj] = *(const u32x4*)((const bf16_t*)base + (size_t)(row0 + ai * 128 + m * 16) * DM + col0 + bj * 128);
#pragma unroll
            for (int ai = 0; ai < 2; ++ai)
#pragma unroll
                for (int m = 0; m < 4; ++m)
#pragma unroll
                    for (int bj = 0; bj < 2; ++bj)
                        *(u32x4*)(out + (size_t)(row0 + ai * 128 + m * 16) * DM + col0 + bj * 128) = pack8(bf4lo(bs[ai][m][bj]) + gv[bj][0] * acc[ai][bj][m][0], bf4hi(bs[ai][m][bj]) + gv[bj][1] * acc[ai][bj][m][1]);
            asm volatile("" ::: "memory");
        }
    }
};
struct EpiSwiGLU {
    static constexpr bool PERM = true;
    bf16_t* O;
    __device__ __forceinline__ void operator()(const f32x4 (&acc)[2][2][4][2], const pg8::Unit& u, int wr, int wc, int fr, int fq) const {
        const int row0 = u.pm * 256 + wr * 64 + fr, col = u.pn * 128 + wc * 32 + 8 * fq;
#pragma unroll
        for (int ai = 0; ai < 2; ++ai)
#pragma unroll
            for (int m = 0; m < 4; ++m) {
                f32x4 g0 = acc[ai][0][m][0], g1 = acc[ai][0][m][1]; const f32x4 u0 = acc[ai][1][m][0], u1 = acc[ai][1][m][1];
#pragma unroll
                for (int j = 0; j < 4; ++j) { g0[j] = silu_f(g0[j]) * u0[j]; g1[j] = silu_f(g1[j]) * u1[j]; }
                u32x4 w; w.x = pk2(g0[0], g0[1]); w.y = pk2(g0[2], g0[3]); w.z = pk2(g1[0], g1[1]); w.w = pk2(g1[2], g1[3]);
                *(u32x4*)(O + (size_t)(row0 + ai * 128 + m * 16) * DFF + col) = w;
            }
    }
};
struct EpiSwiGLU8 {
    static constexpr bool PERM = true;
    bf16_t* O; const float* sa; const float* sb; const int* rowmap;
    __device__ __forceinline__ void operator()(const f32x4 (&acc)[2][2][4][2], const pg8::Unit& u, int wr, int wc, int fr, int fq) const {
        const int row0 = u.pm * 256 + wr * 64 + fr, col = u.pn * 128 + wc * 32 + 8 * fq;
        const float* sbp = sb + (size_t)(u.aux >> 8) * 5632 + u.pn * 256 + wc * 32 + 8 * fq;
        f32x2 sgl[4], sul[4];
        { const f32x4 a0 = *(const f32x4*)sbp, a1 = *(const f32x4*)(sbp + 4), b0 = *(const f32x4*)(sbp + 128), b1 = *(const f32x4*)(sbp + 132);
          sgl[0] = (f32x2){a0.x, a0.y} * -1.4426950408889634f; sgl[1] = (f32x2){a0.z, a0.w} * -1.4426950408889634f; sgl[2] = (f32x2){a1.x, a1.y} * -1.4426950408889634f; sgl[3] = (f32x2){a1.z, a1.w} * -1.4426950408889634f;
          sul[0] = (f32x2){b0.x, b0.y} * -0.6931471805599453f; sul[1] = (f32x2){b0.z, b0.w} * -0.6931471805599453f; sul[2] = (f32x2){b1.x, b1.y} * -0.6931471805599453f; sul[3] = (f32x2){b1.z, b1.w} * -0.6931471805599453f; }
        float srow[8];
#pragma unroll
        for (int q = 0; q < 8; ++q) srow[q] = sa[row0 + (q >> 2) * 128 + (q & 3) * 16];
        asm volatile("" : "+v"(srow[0]), "+v"(srow[1]), "+v"(srow[2]), "+v"(srow[3]), "+v"(srow[4]), "+v"(srow[5]), "+v"(srow[6]), "+v"(srow[7]));
#pragma unroll
        for (int ai = 0; ai < 2; ++ai)
#pragma unroll
            for (int m = 0; m < 4; ++m) {
                const int row = row0 + ai * 128 + m * 16;
                const float s = srow[ai * 4 + m];
                const i32x4 ig0 = __builtin_bit_cast(i32x4, acc[ai][0][m][0]), ig1 = __builtin_bit_cast(i32x4, acc[ai][0][m][1]), iu0 = __builtin_bit_cast(i32x4, acc[ai][1][m][0]), iu1 = __builtin_bit_cast(i32x4, acc[ai][1][m][1]);
                f32x2 arg[4], up[4], d[4], r[4];
#pragma unroll
                for (int p = 0; p < 4; ++p) {
                    const f32x2 ig = {(float)(p < 2 ? ig0[2 * p] : ig1[2 * p - 4]), (float)(p < 2 ? ig0[2 * p + 1] : ig1[2 * p - 3])};
                    const f32x2 iu = {(float)(p < 2 ? iu0[2 * p] : iu1[2 * p - 4]), (float)(p < 2 ? iu0[2 * p + 1] : iu1[2 * p - 3])};
                    arg[p] = ig * (sgl[p] * s); up[p] = iu * (sul[p] * s); }
#pragma unroll
                for (int p = 0; p < 4; ++p) { d[p].x = __builtin_amdgcn_exp2f(arg[p].x); d[p].y = __builtin_amdgcn_exp2f(arg[p].y); }
#pragma unroll
                for (int p = 0; p < 4; ++p) d[p] = d[p] + 1.0f;
#pragma unroll
                for (int p = 0; p < 4; ++p) { r[p].x = __builtin_amdgcn_rcpf(d[p].x); r[p].y = __builtin_amdgcn_rcpf(d[p].y); }
#pragma unroll
                for (int p = 0; p < 4; ++p) up[p] = up[p] * r[p];
                unsigned wv[4];
#pragma unroll
                for (int p = 0; p < 4; ++p) { const f32x2 o = arg[p] * up[p]; wv[p] = pk2(o.x, o.y); }
                u32x4 w; w.x = wv[0]; w.y = wv[1]; w.z = wv[2]; w.w = wv[3];
                *(u32x4*)(O + (size_t)row * DFF + col) = w;
            }
    }
};
template <bool FINAL> struct EpiMoeDownB {
    static constexpr bool PERM = true;
    bf16_t* xb; float* out; const float* g2; const int* rowmap; const float* rowgate;
    __device__ __forceinline__ void operator()(const f32x4 (&acc)[2][2][4][2], const pg8::Unit& u, int wr, int wc, int fr, int fq) const {
        const int row0 = u.pm * 256 + wr * 64 + fr, col0 = u.pn * 256 + wc * 32 + 8 * fq;
        const int bT = __builtin_amdgcn_readfirstlane(rowmap[u.pm * 256]) >> 12;
        f32x4 gvT[2][2];
#pragma unroll
        for (int bj = 0; bj < 2; ++bj)
#pragma unroll
            for (int n = 0; n < 2; ++n) gvT[bj][n] = *(const f32x4*)(g2 + (size_t)bT * (NMOD * DM) + col0 + bj * 128 + 4 * n);
        int tok[8]; float gt[8];
#pragma unroll
        for (int q = 0; q < 8; ++q) { const int row = row0 + (q >> 2) * 128 + (q & 3) * 16; tok[q] = rowmap[row]; gt[q] = rowgate[row]; }
#pragma unroll
        for (int ai = 0; ai < 2; ++ai) {
            u32x4 bs[4][2];
#pragma unroll
            for (int m = 0; m < 4; ++m) { const int tc = tok[ai * 4 + m] < 0 ? 0 : tok[ai * 4 + m];
#pragma unroll
                for (int bj = 0; bj < 2; ++bj) bs[m][bj] = *(const u32x4*)(xb + (size_t)tc * DM + col0 + bj * 128); }
#pragma unroll
            for (int m = 0; m < 4; ++m) { const int q = ai * 4 + m;
                if (tok[q] >= 0) {
                    f32x4 g[2][2];
#pragma unroll
                    for (int bj = 0; bj < 2; ++bj)
#pragma unroll
                        for (int n = 0; n < 2; ++n) g[bj][n] = gvT[bj][n];
                    const int bb = tok[q] >> 12;
                    if (bb != bT) {
#pragma unroll
                        for (int bj = 0; bj < 2; ++bj)
#pragma unroll
                            for (int n = 0; n < 2; ++n) g[bj][n] = *(const f32x4*)(g2 + (size_t)bb * (NMOD * DM) + col0 + bj * 128 + 4 * n);
                    }
#pragma unroll
                    for (int bj = 0; bj < 2; ++bj) {
                        const f32x4 o0 = bf4lo(bs[m][bj]) + g[bj][0] * gt[q] * acc[ai][bj][m][0], o1 = bf4hi(bs[m][bj]) + g[bj][1] * gt[q] * acc[ai][bj][m][1];
                        if constexpr (FINAL) { float* op = out + (size_t)tok[q] * DM + col0 + bj * 128; *(f32x4*)op = o0; *(f32x4*)(op + 4) = o1; }
                        else *(u32x4*)(xb + (size_t)tok[q] * DM + col0 + bj * 128) = pack8(o0, o1);
                    }
                }
            }
            asm volatile("" ::: "memory");
        }
    }
};

#define XB_TMO      128
#define XB_XCNT(j)  (256  + 64 * (j))
#define XB_XSUB(j)  (1280 + 64 * (j))
#define XB_XGEN(j)  (2304 + 64 * (j))
#define XB_TOP      3328
#define XB_TOPGEN   3392
#define XCD_BAR_WORDS 3456
#define XB_SPIN_CAP (1u << 18)
__device__ __forceinline__ unsigned xb_ld(unsigned* p)              { return __hip_atomic_load(p, __ATOMIC_RELAXED, __HIP_MEMORY_SCOPE_AGENT); }
__device__ __forceinline__ unsigned xb_add(unsigned* p, unsigned v) { return __hip_atomic_fetch_add(p, v, __ATOMIC_RELAXED, __HIP_MEMORY_SCOPE_AGENT); }
__device__ __forceinline__ unsigned xb_xcc_id() { return (unsigned)__builtin_amdgcn_s_getreg((3 << 11) | 20) & 0xFu; }
#define XB_SPIN(cond, bar) do { unsigned _sp = 0; while (cond) { __builtin_amdgcn_s_sleep(1); \
    if ((++_sp & 255u) == 0u) { if (xb_ld(&(bar)[XB_TMO])) break; if (_sp > XB_SPIN_CAP) { atomicAdd(&(bar)[XB_TMO], 1u); break; } } } } while (0)
struct XcdBarrier { unsigned* bar; unsigned x; volatile LAS unsigned* st; int w; };
__device__ __forceinline__ XcdBarrier xcd_barrier_post(unsigned* bar, volatile LAS unsigned* st, int wave) {
    XcdBarrier b; b.bar = bar; b.x = xb_xcc_id(); b.st = st; b.w = wave;
    if (wave == 0 && lane_id() == 0) (void)xb_add(&bar[XB_XCNT(b.x)], 1u);
    return b;
}
__device__ __forceinline__ void xcd_barrier_complete(unsigned* bar, unsigned x, unsigned& nloc, unsigned& nx) {
    const unsigned G = gridDim.x * gridDim.y * gridDim.z;
    unsigned sum, cnt, mine, sp = 0u;
    for (;;) {
        sum = 0u; cnt = 0u; mine = 0u;
#pragma unroll
        for (unsigned j = 0; j < 16; ++j) { const unsigned c = xb_ld(&bar[XB_XCNT(j)]); sum += c; cnt += (c > 0u) ? 1u : 0u; mine = (j == x) ? c : mine; }
        if (sum == G) break;
        __builtin_amdgcn_s_sleep(1);
        if ((++sp & 255u) == 0u) { if (xb_ld(&bar[XB_TMO])) break; if (sp > XB_SPIN_CAP) { atomicAdd(&bar[XB_TMO], 1u); break; } }
    }
    nloc = mine > 0u ? mine : 1u; nx = cnt > 0u ? cnt : 1u;
}
__device__ __forceinline__ void xcd_barrier(const XcdBarrier& b) {
    asm volatile("s_waitcnt vmcnt(0)" ::: "memory");
    __syncthreads();
    if (b.w == 0 && lane_id() == 0) {
        unsigned* bar = b.bar; unsigned bx = b.x;
        asm volatile("" : "+s"(bar), "+s"(bx));
        __builtin_amdgcn_s_waitcnt(0);
        unsigned nloc = b.st[0], nx = b.st[1];
        if (nloc == 0u) { xcd_barrier_complete(bar, bx, nloc, nx); b.st[0] = nloc; b.st[1] = nx; }
        const unsigned old = xb_add(&bar[XB_XSUB(bx)], 1u);
        const unsigned gen = old / nloc;
        if (old + 1u == (gen + 1u) * nloc) {
            __builtin_amdgcn_fence(__ATOMIC_RELEASE, "agent");
            asm volatile("s_waitcnt vmcnt(0)" ::: "memory");
            const unsigned og = xb_add(&bar[XB_TOP], 1u);
            const unsigned tg = og / nx;
            if (og + 1u == (tg + 1u) * nx) xb_add(&bar[XB_TOPGEN], 1u);
            else XB_SPIN(xb_ld(&bar[XB_TOPGEN]) == tg, bar);
            __builtin_amdgcn_fence(__ATOMIC_ACQUIRE, "agent");
            xb_add(&bar[XB_XGEN(bx)], 1u);
            asm volatile("s_waitcnt vmcnt(0)" ::: "memory");
        } else {
            XB_SPIN(xb_ld(&bar[XB_XGEN(bx)]) == gen, bar);
            __builtin_amdgcn_fence(__ATOMIC_ACQUIRE, "agent");
            asm volatile("s_waitcnt vmcnt(0)" ::: "memory");
        }
    }
    __syncthreads();
}

struct Frame {
    LAS unsigned char* lds;
    int tid, lane, wave, vcu, G;
    GAS float* out; GAS unsigned char* ws;
};
__device__ __forceinline__ const GAS void* karg_in(int k) {
    const __attribute__((address_space(4))) char* p = (const __attribute__((address_space(4))) char*)__builtin_amdgcn_kernarg_segment_ptr();
    asm volatile("" : "+s"(p));
    return (const GAS void*)*(const void* const __attribute__((address_space(4)))*)(p + 8 * k);
}
enum { I_X = 0, I_C, I_POS, I_ADAW, I_ADAB, I_NMIX, I_NFFN, I_WIN, I_SGUN, I_SGUW, I_SGUB, I_QLN, I_KVLN, I_WUQ, I_WUKV, I_QN, I_KN, I_WOUT, I_FW1, I_FW3, I_FW2, I_RW, I_MW1, I_MW3, I_MW2 };
#define FIN(T, k) ((const T*)(const GAS T*)karg_in(k))
#define WSP(T, off) ((T*)(GAS T*)(F.ws + (off)))
__device__ __forceinline__ Frame phase_frame(const Frame& F0) {
    Frame F = F0; int t = F0.wave * 64 + lane_id(); asm volatile("" : "+v"(t)); { GAS unsigned char* w = F0.ws; GAS float* o = F0.out; asm volatile("" : "+s"(w), "+s"(o)); F.ws = w; F.out = o; } F.tid = t; F.lane = t & 63; return F;
}

__device__ __forceinline__ void transpose_item(const float* W, int K, int N, int k0, int n0, bf16_t* wt0, const float* kscale, LAS float* scr, int lane) {
    f32x4 v[8]; const int rr = lane >> 3, c4 = (lane & 7) * 4;
#pragma unroll
    for (int i = 0; i < 8; ++i) v[i] = __builtin_nontemporal_load((const f32x4*)(W + (size_t)(k0 + 8 * i + rr) * N + n0 + c4));
#pragma unroll
    for (int i = 0; i < 8; ++i) { const int kk = 8 * i + rr; f32x4 x = v[i]; if (kscale) x = x * kscale[k0 + kk];
        scr[kk * 33 + c4] = x.x; scr[kk * 33 + c4 + 1] = x.y; scr[kk * 33 + c4 + 2] = x.z; scr[kk * 33 + c4 + 3] = x.w; }
    LDS_WAIT(); asm volatile("" ::: "memory");
    const int c = lane & 7;
#pragma unroll
    for (int j = 0; j < 4; ++j) { const int n = (lane >> 3) + 8 * j; const LAS float* s = scr + (8 * c) * 33 + n;
        u32x4 o; o.x = pk2(s[0 * 33], s[1 * 33]); o.y = pk2(s[2 * 33], s[3 * 33]); o.z = pk2(s[4 * 33], s[5 * 33]); o.w = pk2(s[6 * 33], s[7 * 33]);
        *(u32x4*)(wt0 + (size_t)n * K + k0 + 8 * c) = o; }
    LDS_WAIT(); asm volatile("" ::: "memory");
}
template <int NPITCH, bool ILV>
__device__ __forceinline__ void quant_strip(const float* W, int s, signed char* WQ, float* sb, int nb, LAS unsigned char* lds, int wave, int lane) {
    LAS float* scr = (LAS float*)(lds + wave * 16896); LAS float* cm = (LAS float*)(lds + 8 * 16896);
    const int k0 = 128 * wave, n0 = 32 * nb; const int rr = lane >> 3, c4 = (lane & 7) * 4;
    f32x4 v[16];
#pragma unroll
    for (int i = 0; i < 16; ++i) v[i] = __builtin_nontemporal_load((const f32x4*)(W + (size_t)(k0 + 8 * i + rr) * NPITCH + n0 + c4));
    float m0 = 0.f, m1 = 0.f, m2 = 0.f, m3 = 0.f;
#pragma unroll
    for (int i = 0; i < 16; ++i) { const int kk = 8 * i + rr; scr[kk * 33 + c4] = v[i].x; scr[kk * 33 + c4 + 1] = v[i].y; scr[kk * 33 + c4 + 2] = v[i].z; scr[kk * 33 + c4 + 3] = v[i].w;
        m0 = fmaxf(m0, fabsf(v[i].x)); m1 = fmaxf(m1, fabsf(v[i].y)); m2 = fmaxf(m2, fabsf(v[i].z)); m3 = fmaxf(m3, fabsf(v[i].w)); }
#pragma unroll
    for (int o = 8; o < 64; o <<= 1) { const int src = (lane ^ o) << 2;
        m0 = fmaxf(m0, __builtin_bit_cast(float, __builtin_amdgcn_ds_bpermute(src, __builtin_bit_cast(int, m0)))); m1 = fmaxf(m1, __builtin_bit_cast(float, __builtin_amdgcn_ds_bpermute(src, __builtin_bit_cast(int, m1))));
        m2 = fmaxf(m2, __builtin_bit_cast(float, __builtin_amdgcn_ds_bpermute(src, __builtin_bit_cast(int, m2)))); m3 = fmaxf(m3, __builtin_bit_cast(float, __builtin_amdgcn_ds_bpermute(src, __builtin_bit_cast(int, m3)))); }
    if (lane < 8) { cm[wave * 32 + c4] = m0; cm[wave * 32 + c4 + 1] = m1; cm[wave * 32 + c4 + 2] = m2; cm[wave * 32 + c4 + 3] = m3; }
    __syncthreads();
    const int n = lane & 31, half = lane >> 5; const int ng = n0 + n, orow = ILV ? 256 * (ng >> 7) + 128 * s + (ng & 127) : ng;
    float am = 0.f;
#pragma unroll
    for (int w = 0; w < 8; ++w) am = fmaxf(am, cm[w * 32 + n]);
    const float inv = am > 0.f ? 127.0f / am : 0.f;
    if (wave == 0 && half == 0) sb[orow] = am * (1.0f / 127.0f);
    const LAS float* sp = scr + (64 * half) * 33 + n;
#pragma unroll
    for (int q = 0; q < 4; ++q) { u32x4 o;
        o.x = pack_i8x4(sp[(16 * q + 0) * 33] * inv, sp[(16 * q + 1) * 33] * inv, sp[(16 * q + 2) * 33] * inv, sp[(16 * q + 3) * 33] * inv);
        o.y = pack_i8x4(sp[(16 * q + 4) * 33] * inv, sp[(16 * q + 5) * 33] * inv, sp[(16 * q + 6) * 33] * inv, sp[(16 * q + 7) * 33] * inv);
        o.z = pack_i8x4(sp[(16 * q + 8) * 33] * inv, sp[(16 * q + 9) * 33] * inv, sp[(16 * q + 10) * 33] * inv, sp[(16 * q + 11) * 33] * inv);
        o.w = pack_i8x4(sp[(16 * q + 12) * 33] * inv, sp[(16 * q + 13) * 33] * inv, sp[(16 * q + 14) * 33] * inv, sp[(16 * q + 15) * 33] * inv);
        *(u32x4*)(WQ + (size_t)orow * DM + k0 + 64 * half + 16 * q) = o; }
    __syncthreads();
}
__device__ __forceinline__ void up_item(const float* W, int s, bf16_t* WT, int r, LAS float* scr, int lane) {
    const int kb = r / 88, nb = r % 88, n0 = 32 * nb; const int orow = 256 * (n0 >> 7) + 128 * s + (n0 & 127);
    transpose_item(W, DM, DFF, 64 * kb, n0, WT + (size_t)orow * DM, nullptr, scr, lane);
}
__device__ __forceinline__ void down_item(const float* W, bf16_t* WT, int r, LAS float* scr, int lane) {
    const int kb = r / 32, nb = r % 32;
    transpose_item(W, DFF, DM, 64 * kb, 32 * nb, WT + (size_t)(32 * nb) * DFF, nullptr, scr, lane);
}
__device__ __forceinline__ void p0_prologue(const Frame& F0) {
    Frame F = phase_frame(F0);
    {
        LAS float* ca = (LAS float*)(F.lds + 69632); LAS float* red = (LAS float*)(F.lds + 102400);
        if ((int)blockIdx.x < 192) {
            for (int i = F.tid; i < NB * DM; i += NTHR) { const float v = FIN(float, I_C)[i]; ca[i] = v / (1.0f + __expf(-v)); }
            __syncthreads();
        }
        for (int it = blockIdx.x; it < 192; it += F.G) {
            const int l = it / 96, j0 = 64 * (it % 96), cg = F.tid & 63, kg = F.tid >> 6;
            const float* W = FIN(float, I_ADAW) + (size_t)l * DM * (NMOD * DM) + j0 + cg;
            float a[NB];
#pragma unroll
            for (int b = 0; b < NB; ++b) a[b] = 0.f;
#pragma unroll 32
            for (int k = 128 * kg; k < 128 * kg + 128; ++k) { const float w = W[(size_t)k * (NMOD * DM)];
#pragma unroll
                for (int b = 0; b < NB; ++b) a[b] += ca[b * DM + k] * w; }
#pragma unroll
            for (int b = 0; b < NB; ++b) red[(kg * 64 + cg) * NB + b] = a[b];
            __syncthreads();
            { const int b = F.tid >> 6; float s = 0.f;
#pragma unroll
              for (int k2 = 0; k2 < 8; ++k2) s += red[(k2 * 64 + cg) * NB + b];
              WSP(float, WS_MOD)[(size_t)(l * NB + b) * (NMOD * DM) + j0 + cg] = s + FIN(float, I_ADAB)[(size_t)l * (NMOD * DM) + j0 + cg]; }
            __syncthreads();
        }
    }
    for (int it = F.vcu; it < 18 * 88; it += F.G) {
        const int mat = it / 88, nb = it % 88, s = mat & 1;
        if (mat < 2) quant_strip<DFF, true>(s ? FIN(float, I_FW3) : FIN(float, I_FW1), s, (signed char*)(F.ws + WS_WFU), WSP(float, WS_SB), nb, F.lds, F.wave, F.lane);
        else { const int e = (mat - 2) >> 1; quant_strip<DFF, true>((s ? FIN(float, I_MW3) : FIN(float, I_MW1)) + (size_t)e * DM * DFF, s, (signed char*)(F.ws + WS_WMU) + (size_t)e * 5632 * DM, WSP(float, WS_SB) + (size_t)(1 + e) * 5632, nb, F.lds, F.wave, F.lane); }
    }
    for (int it = F.vcu; it < 2 * 46; it += F.G) { const int l = it / 46, nb = it % 46;
        quant_strip<D_IN, false>(FIN(float, I_WIN) + (size_t)l * DM * D_IN, 0, (signed char*)(F.ws + WS_WIN) + (size_t)l * D_INP * DM, WSP(float, WS_SBIN) + l * D_INP, nb, F.lds, F.wave, F.lane); }
    LAS float* scr = (LAS float*)(F.lds + F.wave * 8704);
    const int gw = F.vcu * NWAVES + F.wave, NGW = F.G * NWAVES;
    constexpr int GI = 1408, NITEMS = 29 * GI;
    for (int it = gw; it < NITEMS; it += NGW) {
        const int grp = it / GI; int r = it % GI;
        if (grp < 2) { const int l = grp;
            if (r < 736) continue;
            r -= 736;
            if (r < 96) { transpose_item(FIN(float, I_WUQ) + (size_t)l * QLORA * 768, QLORA, 768, 64 * (r / 24), 32 * (r % 24), WSP(bf16_t, WS_WUQ) + ((size_t)l * 768 + 32 * (r % 24)) * QLORA, FIN(float, I_QLN) + l * QLORA, scr, F.lane); continue; } r -= 96;
            if (r < 64) { transpose_item(FIN(float, I_WUKV) + (size_t)l * KVLORA * 1024, KVLORA, 1024, 64 * (r / 32), 32 * (r % 32), WSP(bf16_t, WS_WUKV) + ((size_t)l * 1024 + 32 * (r % 32)) * KVLORA, FIN(float, I_KVLN) + l * KVLORA, scr, F.lane); continue; } r -= 64;
            transpose_item(FIN(float, I_WOUT) + (size_t)l * DM * DM, DM, DM, 64 * (r / 32), 32 * (r % 32), WSP(bf16_t, WS_WOUT) + ((size_t)l * DM + 32 * (r % 32)) * DM, nullptr, scr, F.lane); continue; }
        if (grp == 2 || grp == 3) continue;
        if (grp == 4) { down_item(FIN(float, I_FW2), WSP(bf16_t, WS_WFD), r, scr, F.lane); continue; }
        const int e = (grp - 5) / 3, wh = (grp - 5) % 3;
        if (wh == 2) down_item(FIN(float, I_MW2) + (size_t)e * DFF * DM, WSP(bf16_t, WS_WMD) + (size_t)e * DM * DFF, r, scr, F.lane);
    }
    const int gt = F.vcu * NTHR + F.tid, NGT = F.G * NTHR;
    for (int i = gt; i < 2 * 64 * DM / 16; i += NGT) { const int l = i / (64 * DM / 16), o = i % (64 * DM / 16); *(u32x4*)((signed char*)(F.ws + WS_WIN) + ((size_t)l * D_INP + D_IN) * DM + (size_t)o * 16) = (u32x4){0u, 0u, 0u, 0u}; }
    for (int i = gt; i < 2 * 64; i += NGT) WSP(float, WS_SBIN)[(i >> 6) * D_INP + D_IN + (i & 63)] = 0.f;
    for (int i = gt; i < 2 * NGRP * CHUNK * CHUNK; i += NGT) { const int t = (i >> 7) & 127, s = i & 127; WSP(bf16_t, WS_SGUW)[i] = (bf16_t)f2bf(s <= t ? FIN(float, I_SGUW)[i] : 0.f); }
    for (int it = gt; it < NTOK * 4; it += NGT) {
        const int tok = it >> 2, i0 = 8 * (it & 3);
        const double p = (double)FIN(int, I_POS)[tok]; const double rr = 0.74989420933245582730;   double inv = (i0 == 0) ? 1.0 : (i0 == 8) ? 0.1 : (i0 == 16) ? 0.01 : 0.001;
        float* co = WSP(float, WS_COS) + (size_t)tok * 32; float* si = WSP(float, WS_SIN) + (size_t)tok * 32;
        for (int i = i0; i < i0 + 8; ++i) {
            const double ang = p * inv; inv *= rr;
            const double q = __builtin_rint(ang * 0.63661977236758134308);
            double y = __builtin_fma(-q, 1.57079632679489655800, ang); y = __builtin_fma(-q, 6.12323399573676603587e-17, y);
            const double y2 = y * y;
            double sn = -7.6471637318198164759e-13; sn = sn * y2 + 1.6059043836821614599e-10; sn = sn * y2 - 2.5052108385441718775e-08; sn = sn * y2 + 2.7557319223985890653e-06; sn = sn * y2 - 1.9841269841269841270e-04; sn = sn * y2 + 8.3333333333333333333e-03; sn = sn * y2 - 1.6666666666666666667e-01; sn = y + y * y2 * sn;
            double cs = 4.7794773323873852974e-14; cs = cs * y2 - 1.1470745597729724714e-11; cs = cs * y2 + 2.0876756987868098979e-09; cs = cs * y2 - 2.7557319223985890653e-07; cs = cs * y2 + 2.4801587301587301587e-05; cs = cs * y2 - 1.3888888888888888889e-03; cs = cs * y2 + 4.1666666666666666667e-02; cs = cs * y2 - 0.5; cs = 1.0 + y2 * cs;
            const int qi = (int)((long long)q & 3);
            const double c2 = (qi == 0) ? cs : (qi == 1) ? -sn : (qi == 2) ? -cs : sn;
            const double s2 = (qi == 0) ? sn : (qi == 1) ? cs : (qi == 2) ? -sn : -cs;
            co[i] = (float)c2; si[i] = (float)s2;
        }
    }
}

#define NTL(p) __builtin_nontemporal_load(p)
template <bool ROUTE, bool OUT8, bool XBF>
__device__ __forceinline__ void norm_phase(const Frame& F0, const void* xv, const float* gain, const float* shift, const float* scale, bf16_t* out, int moe_layer) {
    static_assert(OUT8 || !XBF, "bf16 input rows are only written as int8");
    const float* x = (const float*)xv; const bf16_t* xb = (const bf16_t*)xv;
#define NCOL(j) (XBF ? 8 * F.lane + 512 * ((j) >> 1) + 4 * ((j) & 1) : 4 * F.lane + 256 * (j))
    Frame F = phase_frame(F0);
    LAS float* rw = (LAS float*)F.lds;
    LAS int* eL = (LAS int*)(F.lds + 32768);
    if (ROUTE) { const float* R = FIN(float, I_RW) + (size_t)moe_layer * DM * NEXP; for (int i = F.tid; i < DM * NEXP; i += NTHR) rw[(i & 7) * DM + (i >> 3)] = R[i]; __syncthreads(); }
    for (int wg = F.vcu; wg < NTOK / 128; wg += F.G) {
        const int b = wg >> 5;
        f32x4 gs[4], sh[4];
#pragma unroll
        for (int j = 0; j < 4; ++j) { const int col = NCOL(j); const f32x4 g = *(const f32x4*)(gain + col), sc = *(const f32x4*)(scale + (size_t)b * (NMOD * DM) + col); gs[j] = g * (sc + 1.0f); sh[j] = *(const f32x4*)(shift + (size_t)b * (NMOD * DM) + col); }
        f32x4 vn[XBF ? 1 : 4]; u32x4 rn[XBF ? 2 : 1], r1[XBF ? 2 : 1], r2[XBF ? 2 : 1], r3[XBF ? 2 : 1];
        if constexpr (XBF) { const u32x4* xr = (const u32x4*)(xb + (size_t)(wg * 128 + F.wave * 16) * DM) + F.lane; rn[0] = NTL(xr); rn[1] = NTL(xr + 64); r1[0] = NTL(xr + 128); r1[1] = NTL(xr + 192); r2[0] = NTL(xr + 256); r2[1] = NTL(xr + 320); r3[0] = NTL(xr + 384); r3[1] = NTL(xr + 448); }
        else { const f32x4* xr = (const f32x4*)(x + (size_t)(wg * 128 + F.wave * 16) * DM) + F.lane;
#pragma unroll
          for (int j = 0; j < 4; ++j) vn[j] = NTL(xr + 64 * j); }
        for (int rr = 0; rr < 16; ++rr) {
            const int row = wg * 128 + F.wave * 16 + rr;
            f32x4 v[4]; float ss = 0.f;
            if constexpr (XBF) {
                v[0] = bf4lo(rn[0]); v[1] = bf4hi(rn[0]); v[2] = bf4lo(rn[1]); v[3] = bf4hi(rn[1]);
                rn[0] = r1[0]; rn[1] = r1[1]; r1[0] = r2[0]; r1[1] = r2[1]; r2[0] = r3[0]; r2[1] = r3[1];
                if (rr + 4 < 16) { const u32x4* xr = (const u32x4*)(xb + (size_t)(row + 4) * DM) + F.lane; r3[0] = NTL(xr); r3[1] = NTL(xr + 64); }
            } else {
#pragma unroll
                for (int j = 0; j < 4; ++j) v[j] = vn[j];
                if (rr + 1 < 16) { const f32x4* xr = (const f32x4*)(x + (size_t)(row + 1) * DM) + F.lane;
#pragma unroll
                    for (int j = 0; j < 4; ++j) vn[j] = NTL(xr + 64 * j); }
            }
#pragma unroll
            for (int j = 0; j < 4; ++j) ss += (v[j].x * v[j].x + v[j].y * v[j].y) + (v[j].z * v[j].z + v[j].w * v[j].w);
            const float rstd = __builtin_amdgcn_rsqf(wave_sum(ss, F.lane) * (1.0f / DM) + EPS);
#pragma unroll
            for (int j = 0; j < 4; ++j) v[j] = v[j] * rstd * gs[j] + sh[j];
            if constexpr (OUT8) {
                float am = 0.f;
#pragma unroll
                for (int j = 0; j < 4; ++j) am = fmaxf(am, fmaxf(fmaxf(fabsf(v[j].x), fabsf(v[j].y)), fmaxf(fabsf(v[j].z), fabsf(v[j].w))));
                am = wave_max(am, F.lane); const float inv = am > 0.f ? 127.0f * __builtin_amdgcn_rcpf(am) : 0.f;
                if constexpr (XBF) { u32x2* o8 = (u32x2*)((signed char*)out + (size_t)row * DM) + F.lane;
#pragma unroll
                    for (int j2 = 0; j2 < 2; ++j2) { u32x2 w; w.x = pack_i8x4(v[2 * j2].x * inv, v[2 * j2].y * inv, v[2 * j2].z * inv, v[2 * j2].w * inv); w.y = pack_i8x4(v[2 * j2 + 1].x * inv, v[2 * j2 + 1].y * inv, v[2 * j2 + 1].z * inv, v[2 * j2 + 1].w * inv); o8[64 * j2] = w; }
                } else { unsigned* o4 = (unsigned*)((signed char*)out + (size_t)row * DM) + F.lane;
#pragma unroll
                    for (int j = 0; j < 4; ++j) o4[64 * j] = pack_i8x4(v[j].x * inv, v[j].y * inv, v[j].z * inv, v[j].w * inv); }
                if (F.lane == 0) WSP(float, WS_SA)[row] = am * (1.0f / 127.0f);
            } else {
                u32x2* o8 = (u32x2*)(out + (size_t)row * DM) + F.lane;
#pragma unroll
                for (int j = 0; j < 4; ++j) { u32x2 w; w.x = pk2(v[j].x, v[j].y); w.y = pk2(v[j].z, v[j].w); o8[64 * j] = w; }
            }
            if (ROUTE) {
                float pe[NEXP];
#pragma unroll
                for (int e = 0; e < NEXP; ++e) { float s = 0.f;
#pragma unroll
                    for (int j = 0; j < 4; ++j) { const f32x4 w = *(const LAS f32x4*)(rw + e * DM + NCOL(j)); s += (v[j].x * w.x + v[j].y * w.y) + (v[j].z * w.z + v[j].w * w.w); }
                    pe[e] = s; }
                const bool b5 = (F.lane & 32) != 0, b4 = (F.lane & 16) != 0, b3 = (F.lane & 8) != 0;
                float q4[4];
#pragma unroll
                for (int k = 0; k < 4; ++k) { const float keep = b5 ? pe[4 + k] : pe[k], offer = b5 ? pe[k] : pe[4 + k]; q4[k] = keep + __builtin_bit_cast(float, __builtin_amdgcn_ds_bpermute((F.lane ^ 32) << 2, __builtin_bit_cast(int, offer))); }
                float q2[2];
#pragma unroll
                for (int k = 0; k < 2; ++k) { const float keep = b4 ? q4[2 + k] : q4[k], offer = b4 ? q4[k] : q4[2 + k]; q2[k] = keep + __builtin_bit_cast(float, __builtin_amdgcn_ds_bpermute((F.lane ^ 16) << 2, __builtin_bit_cast(int, offer))); }
                float q1; { const float keep = b3 ? q2[1] : q2[0], offer = b3 ? q2[0] : q2[1]; q1 = keep + __builtin_bit_cast(float, __builtin_amdgcn_ds_bpermute((F.lane ^ 8) << 2, __builtin_bit_cast(int, offer))); }
#pragma unroll
                for (int o = 4; o >= 1; o >>= 1) q1 += __builtin_bit_cast(float, __builtin_amdgcn_ds_bpermute((F.lane ^ o) << 2, __builtin_bit_cast(int, q1)));
                float lg[NEXP];
#pragma unroll
                for (int e = 0; e < NEXP; ++e) lg[e] = __builtin_bit_cast(float, __builtin_amdgcn_readlane(__builtin_bit_cast(int, q1), 8 * e));
                int e0 = 0; float v0 = lg[0];
#pragma unroll
                for (int e = 1; e < NEXP; ++e) if (lg[e] > v0) { v0 = lg[e]; e0 = e; }
                int e1 = -1; float v1 = -INFINITY;
#pragma unroll
                for (int e = 0; e < NEXP; ++e) if (e != e0 && lg[e] > v1) { v1 = lg[e]; e1 = e; }
                if (e1 < 0) e1 = (e0 + 1) & 7;
                const float w0 = 1.0f / (1.0f + __expf(v1 - v0));
                if (F.lane == 0) { WSP(int, WS_RTE)[row] = e0 | (e1 << 8); WSP(float, WS_RTW)[2 * row] = w0; WSP(float, WS_RTW)[2 * row + 1] = 1.0f - w0; eL[F.wave * 16 + rr] = e0 | (e1 << 8); }
            }
        }
        if (ROUTE) {
            __syncthreads();
            if (F.tid < 128) {
                const int ee = eL[F.tid]; LAS int* cw = eL + 128;
#pragma unroll
                for (int e = 0; e < NEXP; ++e) { const int c0 = __popcll(__ballot((ee & 0xff) == e)), c1 = __popcll(__ballot(((ee >> 8) & 0xff) == e)); if (F.lane == 0) { cw[F.wave * 16 + e] = c0; cw[F.wave * 16 + 8 + e] = c1; } }
            }
            __syncthreads();
            if (F.tid < 16) WSP(int, WS_CNT)[wg * 16 + F.tid] = eL[128 + F.tid] + eL[128 + 16 + F.tid];
            __syncthreads();
        }
    }
}
#undef NCOL
__device__ __forceinline__ void route_phase(const Frame& F0) {
    Frame F = phase_frame(F0);
    LAS int* part = (LAS int*)F.lds;
    LAS int* tot = (LAS int*)(F.lds + 4096);
    LAS int* cw = (LAS int*)(F.lds + 8192);
    const unsigned* cnt = WSP(const unsigned, WS_CNT);
    for (int wg = F.vcu; wg < NTOK / 128; wg += F.G) {
        { const int t = F.tid & 15, p = F.tid >> 4; int sa = 0, sp = 0;
#pragma unroll
          for (int k = 0; k < 8; ++k) { const int w2 = 8 * p + k; const int v = (int)ld_agent(cnt + w2 * 16 + t); sa += v; sp += (w2 < wg) ? v : 0; }
          part[(p * 16 + t) * 2] = sa; part[(p * 16 + t) * 2 + 1] = sp; }
        int ee = 0, rank0 = 0, rank1 = 0; float w0 = 0.f, w1 = 0.f;
        if (F.tid < 128) {
            const int tok = wg * 128 + F.tid;
            ee = (int)ld_agent(WSP(const unsigned, WS_RTE) + tok);
            w0 = __builtin_bit_cast(float, ld_agent(WSP(const unsigned, WS_RTW) + 2 * tok)); w1 = __builtin_bit_cast(float, ld_agent(WSP(const unsigned, WS_RTW) + 2 * tok + 1));
            const unsigned long long lt = (1ull << F.lane) - 1ull;
#pragma unroll
            for (int e = 0; e < NEXP; ++e) {
                const unsigned long long m0 = __ballot((ee & 0xff) == e), m1 = __ballot(((ee >> 8) & 0xff) == e);
                if ((ee & 0xff) == e) rank0 = __popcll(m0 & lt);
                if (((ee >> 8) & 0xff) == e) rank1 = __popcll(m1 & lt);
                if (F.tid == 0) { cw[e] = __popcll(m0); cw[8 + e] = __popcll(m1); }
            }
        }
        __syncthreads();
        if (F.tid < 16) { int sa = 0, sp = 0; for (int p = 0; p < 32; ++p) { sa += part[(p * 16 + F.tid) * 2]; sp += part[(p * 16 + F.tid) * 2 + 1]; } tot[F.tid] = sp; tot[16 + F.tid] = sa; }
        __syncthreads();
        if (F.tid < 16) { const int s = F.tid >> 3, e = F.tid & 7; int base = 0; for (int e2 = 0; e2 < e; ++e2) base += (tot[16 + s * 8 + e2] + 255) & ~255; tot[32 + F.tid] = base; }
        __syncthreads();
        if (F.tid < 128) {
            const int tok = wg * 128 + F.tid; const int e0 = ee & 0xff, e1 = (ee >> 8) & 0xff;
            const int p0 = tot[32 + e0] + tot[e0] + rank0 + (F.tid >= 64 ? cw[e0] : 0), p1 = tot[32 + 8 + e1] + tot[8 + e1] + rank1 + (F.tid >= 64 ? cw[8 + e1] : 0);
            const float sat = WSP(const float, WS_SA)[tok];
            WSP(int, WS_RMAP)[p0] = tok; WSP(float, WS_RGATE)[p0] = w0; WSP(float, WS_RSA)[p0] = sat;
            WSP(int, WS_RMAP)[SLOTROWS + p1] = tok; WSP(float, WS_RGATE)[SLOTROWS + p1] = w1; WSP(float, WS_RSA)[SLOTROWS + p1] = sat;
        }
        if (wg == 0 && F.tid < 16) {
            const int s = F.tid >> 3, e = F.tid & 7; const int base = tot[32 + F.tid], all = tot[16 + F.tid], end = base + ((all + 255) & ~255);
            int* rmap = WSP(int, WS_RMAP) + s * SLOTROWS; float* rgate = WSP(float, WS_RGATE) + s * SLOTROWS;
#pragma clang loop vectorize(disable) unroll(disable)
            for (int p = base + all; p < end; ++p) { rmap[p] = -1; rgate[p] = 0.f; WSP(float, WS_RSA)[s * SLOTROWS + p] = 0.f; }
            int* tab = WSP(int, WS_TAB);
#pragma clang loop vectorize(disable) unroll(disable)
            for (int pm = base >> 8; pm < (end >> 8); ++pm) tab[16 + 136 * s + pm] = e;
            if (e == 7) tab[s] = end >> 8;
        }
        __syncthreads();
    }
}
constexpr int TAIL_S = 11;
__device__ __forceinline__ int moe_prep(const Frame& F0, int slot, int mode) {
    Frame F = phase_frame(F0);
    LAS int* ul = (LAS int*)(F.lds + LDS_UL_OFF + (mode == 2 ? 256 : 0)); LAS int* idx = (LAS int*)(F.lds + LDS_IDX_OFF);
    const unsigned* tab = WSP(const unsigned, WS_TAB); const unsigned* rmap = WSP(const unsigned, WS_RMAP) + slot * SLOTROWS;
    const int nT = (int)ld_agent(tab + slot);
    int n = 0;
    if (mode == 2) {
        const int items = (nT - 128) * 4 * TAIL_S;
        for (int i = 0; i < 2; ++i) { const int it = (int)blockIdx.x + i * F.G; if (it >= items) break; n = i + 1;
            const int un = it / TAIL_S, kc = it % TAIL_S, pm = 128 + (un >> 2), pn = un & 3;
            if (F.tid == 0) { ul[4 * i] = pm; ul[4 * i + 1] = pn; ul[4 * i + 2] = (int)ld_agent(tab + 16 + 136 * slot + pm); ul[4 * i + 3] = kc; } }
    } else {
        pg8::StaticOrder so; so.init(mode == 0 ? nT : 128, mode == 0 ? 22 : 4, F.G, (int)blockIdx.x);
        { const long last = (long)so.nwg - 1 - so.c; n = last < 0 ? 0 : (int)(last / so.G) + 1; if (n > 12) n = 12; }
        if (F.tid < n) { int pm, pn; so.tile(F.tid, pm, pn); ul[4 * F.tid] = pm; ul[4 * F.tid + 1] = pn; ul[4 * F.tid + 2] = (int)ld_agent(tab + 16 + 136 * slot + pm); ul[4 * F.tid + 3] = 0; }
        if (mode == 0) {
            __syncthreads();
            for (int j = F.tid; j < n * 256; j += NTHR) { const int t = (int)ld_agent(rmap + ul[4 * (j >> 8)] * 256 + (j & 255)); idx[j] = t < 0 ? 0 : t; }
        }
    }
    __syncthreads();
    return n;
}
constexpr size_t WS_SCRA = WS_WIN, WS_SCRB = WS_ACT + (size_t)SLOTROWS * DFF * 2; constexpr int SCRA_ITEMS = 220;
static_assert(WS_SCRA + (size_t)SCRA_ITEMS * 131072 <= WS_WMU && WS_SCRB + (size_t)(7 * 4 * TAIL_S - SCRA_ITEMS) * 131072 <= WS_END, "split-K scratch");
__device__ __forceinline__ size_t scr_off(int item) { return item < SCRA_ITEMS ? WS_SCRA + (size_t)item * 131072 : WS_SCRB + (size_t)(item - SCRA_ITEMS) * 131072; }
struct EpiPartial {
    static constexpr bool PERM = false;
    unsigned char* ws;
    __device__ __forceinline__ void operator()(const f32x4 (&acc)[2][2][4][2], const pg8::Unit& u, int wr, int wc, int fr, int fq) const {
        const int item = ((u.pm - 128) * 4 + u.pn) * TAIL_S + (u.aux & 15); int ln = fq * 16 + fr; asm volatile("" : "+v"(ln)); const int tid = (wr * 4 + wc) * 64 + ln;
        u32x4* dst = (u32x4*)(ws + scr_off(item)) + tid;
        float one; asm volatile("v_mov_b32 %0, 1.0" : "=v"(one));
#pragma unroll
        for (int ai = 0; ai < 2; ++ai)
#pragma unroll
            for (int bj = 0; bj < 2; ++bj)
#pragma unroll
                for (int m = 0; m < 4; ++m) { const f32x4 v0 = acc[ai][bj][m][0] * one, v1 = acc[ai][bj][m][1] * one;
                    u32x4 w; w.x = pk2(v0[0], v0[1]); w.y = pk2(v0[2], v0[3]); w.z = pk2(v1[0], v1[1]); w.w = pk2(v1[2], v1[3]);
                    dst[((ai * 2 + bj) * 4 + m) * 512] = w; }
    }
};
template <bool FINAL> __device__ __forceinline__ void moe_tail_reduce(const Frame& F0, int slot, const float* g2) {
    Frame F = phase_frame(F0);
    const int nT = (int)ld_agent(WSP(const unsigned, WS_TAB) + slot);
    const int nitems = (nT - 128) * 4 * 16;
    const int* rowmap = WSP(const int, WS_RMAP) + slot * SLOTROWS; const float* rowgate = WSP(const float, WS_RGATE) + slot * SLOTROWS;
    const int wid = F.wave, wr = wid >> 2, wc = wid & 3, fr = F.lane & 15, fq = F.lane >> 4;
    for (int it = blockIdx.x; it < nitems; it += F.G) {
        const int un = it >> 4, rgi = it & 15, ai = rgi >> 3, bj = (rgi >> 2) & 1, m = rgi & 3, pm = 128 + (un >> 2), pn = un & 3;
        f32x4 s0 = {0.f, 0.f, 0.f, 0.f}, s1 = {0.f, 0.f, 0.f, 0.f};
#pragma unroll
        for (int kc = 0; kc < TAIL_S; ++kc) { const u32x4 w = *((const u32x4*)(F.ws + scr_off(un * TAIL_S + kc)) + rgi * 512 + F.tid);
            s0.x += bflo(w.x); s0.y += bfhi(w.x); s0.z += bflo(w.y); s0.w += bfhi(w.y); s1.x += bflo(w.z); s1.y += bfhi(w.z); s1.z += bflo(w.w); s1.w += bfhi(w.w); }
        const int row = pm * 256 + ai * 128 + wr * 64 + m * 16 + fr; const int tok = rowmap[row]; const float gt = rowgate[row];
        if (tok >= 0) { const int col = pn * 256 + bj * 128 + wc * 32 + 4 * fq; bf16_t* xp = WSP(bf16_t, WS_XB) + (size_t)tok * DM + col; const float* gp = g2 + (size_t)(tok >> 12) * (NMOD * DM) + col;
            const u32x2 x0 = *(const u32x2*)xp, x1 = *(const u32x2*)(xp + 16);
            const f32x4 o0 = (f32x4){bflo(x0.x), bfhi(x0.x), bflo(x0.y), bfhi(x0.y)} + *(const f32x4*)gp * gt * s0, o1 = (f32x4){bflo(x1.x), bfhi(x1.x), bflo(x1.y), bfhi(x1.y)} + *(const f32x4*)(gp + 16) * gt * s1;
            if constexpr (FINAL) { float* op = (float*)F.out + (size_t)tok * DM + col; *(f32x4*)op = o0; *(f32x4*)(op + 16) = o1; }
            else { u32x2 w0, w1; w0.x = pk2(o0[0], o0[1]); w0.y = pk2(o0[2], o0[3]); w1.x = pk2(o1[0], o1[1]); w1.y = pk2(o1[2], o1[3]); *(u32x2*)xp = w0; *(u32x2*)(xp + 16) = w1; } }
    }
}

constexpr int VS = 1088;
constexpr int WQS = 528, WKS = 272;
constexpr int STQ_OFF = 102400, STQ_W = 6656, STK_OFF = 69632, STK_W = 8704;
constexpr int GAIN_OFF = 155648;
static_assert(STQ_OFF + 8 * STQ_W <= GAIN_OFF && STK_OFF + 8 * STK_W <= GAIN_OFF && 128 * VS <= GAIN_OFF && GAIN_OFF + 2 * 192 * 4 <= MISC_OFF, "gain table");
static_assert(192 * WQS <= STQ_OFF && STQ_OFF + 8 * STQ_W <= MISC_OFF && 256 * WKS <= STK_OFF && STK_OFF + 8 * STK_W <= MISC_OFF && 128 * VS <= MISC_OFF, "mid-phase LDS");
__device__ __forceinline__ float ssq8(u32x4 w) { return (bflo(w.x) * bflo(w.x) + bfhi(w.x) * bfhi(w.x)) + (bflo(w.y) * bflo(w.y) + bfhi(w.y) * bfhi(w.y)) + (bflo(w.z) * bflo(w.z) + bfhi(w.z) * bfhi(w.z)) + (bflo(w.w) * bflo(w.w) + bfhi(w.w) * bfhi(w.w)); }
template <int NB, int RS>
__device__ __forceinline__ void store_rows_via_lds(LAS unsigned char* stg, const f32x16& v0, const f32x16& v1, const f32x16& v2, const f32x16& v3, float f, const LAS float* gain, bf16_t* dst, int ld, int lane_) {
    int lane = lane_; asm volatile("" : "+v"(lane)); const int r = lane & 31, hi = lane >> 5;
#pragma unroll
    for (int nb = 0; nb < NB; ++nb) { const f32x16& v = nb == 0 ? v0 : nb == 1 ? v1 : nb == 2 ? v2 : v3;
#pragma unroll
        for (int g4 = 0; g4 < 4; ++g4) { f32x4 gq = {f, f, f, f}; if (gain) gq = *(const LAS f32x4*)(gain + 32 * nb + 8 * g4 + 4 * hi) * f;
            u32x2 w; w.x = pk2(v[4 * g4] * gq.x, v[4 * g4 + 1] * gq.y); w.y = pk2(v[4 * g4 + 2] * gq.z, v[4 * g4 + 3] * gq.w); *(LAS u32x2*)(stg + r * RS + (32 * nb + 8 * g4 + 4 * hi) * 2) = w; } }
    LDS_WAIT();
    constexpr int CPR = NB * 4;
#pragma unroll
    for (int i = 0; i < (32 * CPR) / 64; ++i) { const int idx = lane + 64 * i, row = idx / CPR, ch = idx % CPR; const u32x4 w = *(const LAS u32x4*)(stg + row * RS + ch * 16); *(u32x4*)(dst + (size_t)row * ld + ch * 8) = w; }
    LDS_WAIT();
}
__device__ __forceinline__ void mid_phase(const Frame& F0, int l) {
    Frame F = phase_frame(F0);
    const int lane = F.lane, wid = F.wave;
    { LAS float* gl = (LAS float*)(F.lds + GAIN_OFF); if (F.tid < 2 * QKH) gl[F.tid] = F.tid < QKH ? FIN(float, I_QN)[l * QKH + F.tid] : FIN(float, I_KN)[l * QKH + F.tid - QKH]; }
#ifndef NO_PART_A
    for (int ch = F.vcu; ch < NTOK / CHUNK; ch += F.G) {
        const int row0 = ch * CHUNK; const int r = lane & 31, hi = lane >> 5;
        const bf16_t* U = WSP(const bf16_t, WS_U); const bf16_t* GV = WSP(const bf16_t, WS_GV); bf16_t* CC = WSP(bf16_t, WS_H);
        const int g = wid; const bf16_t* Wg = WSP(const bf16_t, WS_SGUW) + (size_t)(l * NGRP + g) * CHUNK * CHUNK;
        bf16x8 wf[20];
#pragma unroll
        for (int mb = 0; mb < 4; ++mb)
#pragma unroll
            for (int ks = 0; ks <= 2 * mb + 1; ++ks) wf[mb * (mb + 1) + ks] = *(const bf16x8*)(Wg + (size_t)(32 * mb + r) * CHUNK + 16 * ks + 8 * hi);
        {
            const int c = lane & 7;
#pragma unroll 1
            for (int it = 0; it < 2; ++it) { const int t = wid * 16 + it * 8 + (lane >> 3);
                const u32x4* src = (const u32x4*)(GV + (size_t)(row0 + t) * SGU_W + 8 * c);
                u32x4 raw[8];
#pragma unroll
                for (int j = 0; j < 8; ++j) raw[j] = __builtin_nontemporal_load(src + 8 * j);
                float s = 0.f;
#pragma unroll
                for (int j = 0; j < 8; ++j) s += ((bflo(raw[j].x) + bfhi(raw[j].x)) + (bflo(raw[j].y) + bfhi(raw[j].y))) + ((bflo(raw[j].z) + bfhi(raw[j].z)) + (bflo(raw[j].w) + bfhi(raw[j].w)));
#pragma unroll
                for (int o = 1; o < 8; o <<= 1) s += __builtin_bit_cast(float, __builtin_amdgcn_ds_bpermute((lane ^ o) << 2, __builtin_bit_cast(int, s)));
                const float mean = s * (1.0f / SGU_W); float q = 0.f;
#pragma unroll
                for (int j = 0; j < 8; ++j) { const float d0 = bflo(raw[j].x) - mean, d1 = bfhi(raw[j].x) - mean, d2 = bflo(raw[j].y) - mean, d3 = bfhi(raw[j].y) - mean, d4 = bflo(raw[j].z) - mean, d5 = bfhi(raw[j].z) - mean, d6 = bflo(raw[j].w) - mean, d7 = bfhi(raw[j].w) - mean;
                    q += ((d0 * d0 + d1 * d1) + (d2 * d2 + d3 * d3)) + ((d4 * d4 + d5 * d5) + (d6 * d6 + d7 * d7)); }
#pragma unroll
                for (int o = 1; o < 8; o <<= 1) q += __builtin_bit_cast(float, __builtin_amdgcn_ds_bpermute((lane ^ o) << 2, __builtin_bit_cast(int, q)));
                const float rstd = __builtin_amdgcn_rsqf(q * (1.0f / SGU_W) + EPS);
#pragma unroll
                for (int j = 0; j < 8; ++j) { u32x4 w;
                    w.x = pk2((bflo(raw[j].x) - mean) * rstd, (bfhi(raw[j].x) - mean) * rstd); w.y = pk2((bflo(raw[j].y) - mean) * rstd, (bfhi(raw[j].y) - mean) * rstd);
                    w.z = pk2((bflo(raw[j].z) - mean) * rstd, (bfhi(raw[j].z) - mean) * rstd); w.w = pk2((bflo(raw[j].w) - mean) * rstd, (bfhi(raw[j].w) - mean) * rstd);
                    *(LAS u32x4*)(F.lds + t * VS + (8 * c + 64 * j) * 2) = w; }
            }
        }
        __syncthreads();
        {
            const int i16 = lane & 15, q4 = i16 >> 2, p4 = i16 & 3, g2 = (lane >> 4) & 1;
            const LAS unsigned char* vb = F.lds + (8 * hi + q4) * VS + (64 * g + 16 * g2 + 4 * p4) * 2;
            u32x4 uv[16];
#pragma unroll
            for (int i = 0; i < 16; ++i) uv[i] = __builtin_nontemporal_load((const u32x4*)(U + (size_t)(row0 + i * 8 + (lane >> 3)) * SGU_W + 64 * g + 8 * (lane & 7)));
            asm volatile("" ::: "memory");
#pragma unroll
            for (int mb = 3; mb >= 0; --mb) {
                f32x16 a0 = {}, a1 = {};
#pragma unroll
                for (int ks = 0; ks <= 2 * mb + 1; ++ks) {
                    const s16x4 l0 = vtr(vb + (16 * ks) * VS), h0 = vtr(vb + (16 * ks + 4) * VS), l1 = vtr(vb + (16 * ks) * VS + 64), h1 = vtr(vb + (16 * ks + 4) * VS + 64);
                    const bf16x8 b0 = {l0[0], l0[1], l0[2], l0[3], h0[0], h0[1], h0[2], h0[3]}, b1 = {l1[0], l1[1], l1[2], l1[3], h1[0], h1[1], h1[2], h1[3]};
                    a0 = __builtin_amdgcn_mfma_f32_32x32x16_bf16(wf[mb * (mb + 1) + ks], b0, a0, 0, 0, 0); a1 = __builtin_amdgcn_mfma_f32_32x32x16_bf16(wf[mb * (mb + 1) + ks], b1, a1, 0, 0, 0);
                }
                LDS_WAIT();
#pragma unroll
                for (int rg = 0; rg < 16; ++rg) { LAS bf16_t* sp = (LAS bf16_t*)(F.lds + (32 * mb + crow(rg, hi)) * VS + (64 * g + r) * 2); sp[0] = (bf16_t)f2bf(a0[rg]); sp[32] = (bf16_t)f2bf(a1[rg]); }
                asm volatile("" ::: "memory");
            }
            LDS_WAIT();
            const float* bg = FIN(float, I_SGUB) + (size_t)(l * NGRP + g) * CHUNK;
            const f32x4 gn0 = *(const f32x4*)(FIN(float, I_SGUN) + l * SGU_W + 64 * g + 8 * (lane & 7)), gn1 = *(const f32x4*)(FIN(float, I_SGUN) + l * SGU_W + 64 * g + 8 * (lane & 7) + 4);
#pragma unroll
            for (int i = 0; i < 16; ++i) { const int t = i * 8 + (lane >> 3), c8 = lane & 7;
                const u32x4 sv = *(const LAS u32x4*)(F.lds + t * VS + (64 * g + 8 * c8) * 2);
                const u32x4 uvi = uv[i]; const float bias = bg[t];
                u32x4 o; o.x = pk2(bflo(uvi.x) * (bflo(sv.x) * gn0.x + bias), bfhi(uvi.x) * (bfhi(sv.x) * gn0.y + bias)); o.y = pk2(bflo(uvi.y) * (bflo(sv.y) * gn0.z + bias), bfhi(uvi.y) * (bfhi(sv.y) * gn0.w + bias));
                o.z = pk2(bflo(uvi.z) * (bflo(sv.z) * gn1.x + bias), bfhi(uvi.z) * (bfhi(sv.z) * gn1.y + bias)); o.w = pk2(bflo(uvi.w) * (bflo(sv.w) * gn1.z + bias), bfhi(uvi.w) * (bfhi(sv.w) * gn1.w + bias));
                *(u32x4*)(CC + (size_t)(row0 + t) * DM + 64 * g + 8 * c8) = o; }
        }
        __syncthreads();
    }
#endif
#ifndef NO_PART_B
    for (int un = F.vcu; un < (NTOK / 512) * NH; un += F.G) {
        const int tg = un >> 2, h = un & 3;
        { const u32x4* src = (const u32x4*)(WSP(const bf16_t, WS_WUQ) + ((size_t)l * 768 + 192 * h) * QLORA); int t2 = F.tid; asm volatile("" : "+v"(t2));
#pragma unroll
          for (int i = 0; i < 12; ++i) { const int c = t2 + 512 * i; *(LAS u32x4*)(F.lds + (c >> 5) * WQS + (c & 31) * 16) = src[c]; } }
        __syncthreads();
#pragma unroll 1
        for (int blk = 0; blk < 2; ++blk) {
            int ln_ = lane; asm volatile("" : "+v"(ln_)); const int r = ln_ & 31, hi = ln_ >> 5;
            const int tblk = tg * 16 + wid * 2 + blk;
            const int tok = tblk * 32 + r; const int b = tok >> 12;
            u32x4 bq[16]; float ssl = 0.f;
            { const u32x4* cq = (const u32x4*)WSP(const bf16_t, WS_CQ) + ((size_t)tblk * 32 + hi) * 32 + r;
#pragma unroll
              for (int ks = 0; ks < 16; ++ks) bq[ks] = cq[ks * 64]; }
#pragma unroll
            for (int ks = 0; ks < 16; ++ks) ssl += ssq8(bq[ks]);
            asm volatile("" : "+v"(ssl));
            f32x16 acc[6];
#pragma unroll
            for (int nb = 0; nb < 6; ++nb) acc[nb] = f32x16{};
            const LAS unsigned char* wb = F.lds + r * WQS + 16 * hi; asm volatile("" : "+v"(wb));
            bf16x8 af[2][6];
#pragma unroll
            for (int nb = 0; nb < 6; ++nb) af[0][nb] = *(const LAS bf16x8*)(wb + nb * 32 * WQS);
#pragma unroll
            for (int ks = 0; ks < 16; ++ks) {
                if (ks + 1 < 16) {
#pragma unroll
                    for (int nb = 0; nb < 6; ++nb) af[(ks + 1) & 1][nb] = *(const LAS bf16x8*)(wb + nb * 32 * WQS + 32 * (ks + 1)); }
#pragma unroll
                for (int nb = 0; nb < 6; ++nb) acc[nb] = __builtin_amdgcn_mfma_f32_32x32x16_bf16(af[ks & 1][nb], __builtin_bit_cast(bf16x8, bq[ks]), acc[nb], 0, 0, 0);
                asm volatile("" : "+v"(wb) : "v"(acc[0][0]));
            }
            ssl = half_sum(ssl);
            const float rl = __builtin_amdgcn_rsqf(ssl * (1.0f / QLORA) + EPS);
            float ssq = 0.f;
#pragma unroll
            for (int nb = 0; nb < 6; ++nb)
#pragma unroll
                for (int rg = 0; rg < 16; ++rg) ssq += acc[nb][rg] * acc[nb][rg];
            ssq = half_sum(ssq);
            const float C2 = 0.07216878364870322f * 1.4426950408889634f;
            const float fq = C2 * rl * __builtin_amdgcn_rsqf(ssq * rl * rl * (1.0f / QKH) + EPS);
            const LAS float* qnp = (const LAS float*)(F.lds + GAIN_OFF);
            bf16_t* qo = WSP(bf16_t, WS_Q) + ((size_t)(b * NH + h) * SEQ + (tblk * 32 & 4095)) * QKH;
            LAS unsigned char* stg = F.lds + STQ_OFF + wid * STQ_W;
            store_rows_via_lds<3, 208>(stg, acc[0], acc[1], acc[2], acc[2], fq, qnp, qo, QKH, ln_);
            const GAS float* cs_g = (const GAS float*)WSP(const float, WS_COS) + (size_t)tok * 32; const GAS float* sn_g = (const GAS float*)WSP(const float, WS_SIN) + (size_t)tok * 32; asm volatile("" : "+v"(cs_g), "+v"(sn_g)); const float* cs = (const float*)cs_g; const float* sn = (const float*)sn_g;
            f32x4 cvs[4], svs[4];
#pragma unroll
            for (int g4 = 0; g4 < 4; ++g4) { cvs[g4] = *(const f32x4*)(cs + 8 * g4 + 4 * hi); svs[g4] = *(const f32x4*)(sn + 8 * g4 + 4 * hi); }
#pragma unroll
            for (int g4 = 0; g4 < 4; ++g4) { const int i0 = 8 * g4 + 4 * hi; const f32x4 n0 = *(const LAS f32x4*)(qnp + 96 + i0), n1 = *(const LAS f32x4*)(qnp + 128 + i0), n2 = *(const LAS f32x4*)(qnp + 160 + i0), cv = cvs[g4], sv = svs[g4];
#pragma unroll
                for (int j = 0; j < 4; ++j) { const float x1 = acc[4][4 * g4 + j] * fq * n1[j], x2 = acc[5][4 * g4 + j] * fq * n2[j]; acc[3][4 * g4 + j] *= fq * n0[j]; acc[4][4 * g4 + j] = x1 * cv[j] - x2 * sv[j]; acc[5][4 * g4 + j] = x2 * cv[j] + x1 * sv[j]; } }
            store_rows_via_lds<3, 208>(stg, acc[3], acc[4], acc[5], acc[5], 1.0f, nullptr, qo + 96, QKH, ln_);
        }
        __syncthreads();
        { const u32x4* src = (const u32x4*)(WSP(const bf16_t, WS_WUKV) + ((size_t)l * 1024 + 256 * h) * KVLORA); int t2 = F.tid; asm volatile("" : "+v"(t2));
#pragma unroll
          for (int i = 0; i < 8; ++i) { const int c = t2 + 512 * i; *(LAS u32x4*)(F.lds + (c >> 4) * WKS + (c & 15) * 16) = src[c]; } }
        __syncthreads();
#pragma unroll 1
        for (int blk = 0; blk < 2; ++blk) {
            int ln_ = lane; asm volatile("" : "+v"(ln_)); const int r = ln_ & 31, hi = ln_ >> 5;
            const int tblk = tg * 16 + wid * 2 + blk;
            const int tok = tblk * 32 + r; const int b = tok >> 12;
            u32x4 bk[8]; float ssl = 0.f;
            { const u32x4* ck = (const u32x4*)WSP(const bf16_t, WS_CKV) + ((size_t)tblk * 16 + hi) * 32 + r;
#pragma unroll
              for (int ks = 0; ks < 8; ++ks) bk[ks] = ck[ks * 64]; }
#pragma unroll
            for (int ks = 0; ks < 8; ++ks) ssl += ssq8(bk[ks]);
            asm volatile("" : "+v"(ssl));
            f32x16 rp[2];
            { const u32x2* kr = (const u32x2*)WSP(const bf16_t, WS_KR) + ((size_t)tblk * 16 + hi) * 32 + r;
#pragma unroll
              for (int g4 = 0; g4 < 4; ++g4) { const u32x2 a = kr[(2 * g4) * 32], c = kr[(8 + 2 * g4) * 32];
                rp[0][4 * g4] = bflo(a.x); rp[0][4 * g4 + 1] = bfhi(a.x); rp[0][4 * g4 + 2] = bflo(a.y); rp[0][4 * g4 + 3] = bfhi(a.y);
                rp[1][4 * g4] = bflo(c.x); rp[1][4 * g4 + 1] = bfhi(c.x); rp[1][4 * g4 + 2] = bflo(c.y); rp[1][4 * g4 + 3] = bfhi(c.y); } }
            f32x16 acc[4];
#pragma unroll
            for (int nb = 0; nb < 4; ++nb) acc[nb] = f32x16{};
            const LAS unsigned char* wb = F.lds + r * WKS + 16 * hi; asm volatile("" : "+v"(wb));
            bf16x8 af[2][4];
#pragma unroll
            for (int nb = 0; nb < 4; ++nb) af[0][nb] = *(const LAS bf16x8*)(wb + nb * 32 * WKS);
#pragma unroll
            for (int ks = 0; ks < 8; ++ks) {
                if (ks + 1 < 8) {
#pragma unroll
                    for (int nb = 0; nb < 4; ++nb) af[(ks + 1) & 1][nb] = *(const LAS bf16x8*)(wb + nb * 32 * WKS + 32 * (ks + 1)); }
#pragma unroll
                for (int nb = 0; nb < 4; ++nb) acc[nb] = __builtin_amdgcn_mfma_f32_32x32x16_bf16(af[ks & 1][nb], __builtin_bit_cast(bf16x8, bk[ks]), acc[nb], 0, 0, 0);
                asm volatile("" : "+v"(wb) : "v"(acc[0][0]));
            }
            ssl = half_sum(ssl);
            const float rl = __builtin_amdgcn_rsqf(ssl * (1.0f / KVLORA) + EPS);
            float ssq = 0.f, ssr = 0.f;
#pragma unroll
            for (int nb = 0; nb < 4; ++nb)
#pragma unroll
                for (int rg = 0; rg < 16; ++rg) ssq += acc[nb][rg] * acc[nb][rg];
#pragma unroll
            for (int j = 0; j < 16; ++j) ssr += rp[0][j] * rp[0][j] + rp[1][j] * rp[1][j];
            ssq = ssq * rl * rl + ssr;
            ssq = half_sum(ssq);
            const float rn = __builtin_amdgcn_rsqf(ssq * (1.0f / QKH) + EPS);
            const LAS float* knp = (const LAS float*)(F.lds + GAIN_OFF) + QKH;
            bf16_t* ko = WSP(bf16_t, WS_K) + ((size_t)(b * NH + h) * SEQ + (tblk * 32 & 4095)) * QKH;
            LAS unsigned char* stg = F.lds + STK_OFF + wid * STK_W;
            store_rows_via_lds<4, 272>(stg, acc[0], acc[1], acc[2], acc[3], rl * rn, knp, ko, QKH, ln_);
            const GAS float* cs_g = (const GAS float*)WSP(const float, WS_COS) + (size_t)tok * 32; const GAS float* sn_g = (const GAS float*)WSP(const float, WS_SIN) + (size_t)tok * 32; asm volatile("" : "+v"(cs_g), "+v"(sn_g)); const float* cs = (const float*)cs_g; const float* sn = (const float*)sn_g;
            f32x4 cvs[4], svs[4];
#pragma unroll
            for (int g4 = 0; g4 < 4; ++g4) { cvs[g4] = *(const f32x4*)(cs + 8 * g4 + 4 * hi); svs[g4] = *(const f32x4*)(sn + 8 * g4 + 4 * hi); }
#pragma unroll
            for (int g4 = 0; g4 < 4; ++g4) { const int i0 = 8 * g4 + 4 * hi; const f32x4 n1 = *(const LAS f32x4*)(knp + 128 + i0), n2 = *(const LAS f32x4*)(knp + 160 + i0), cv = cvs[g4], sv = svs[g4];
#pragma unroll
                for (int j = 0; j < 4; ++j) { const float y1 = rp[0][4 * g4 + j] * rn * n1[j], y2 = rp[1][4 * g4 + j] * rn * n2[j]; rp[0][4 * g4 + j] = y1 * cv[j] - y2 * sv[j]; rp[1][4 * g4 + j] = y2 * cv[j] + y1 * sv[j]; } }
            store_rows_via_lds<2, 272>(stg, rp[0], rp[1], rp[1], rp[1], 1.0f, nullptr, ko + 128, QKH, ln_);
#pragma unroll
            for (int nb = 0; nb < 4; ++nb) acc[nb] = f32x16{};
#pragma unroll
            for (int nb = 0; nb < 4; ++nb) af[0][nb] = *(const LAS bf16x8*)(wb + (128 + nb * 32) * WKS);
#pragma unroll
            for (int ks = 0; ks < 8; ++ks) {
                if (ks + 1 < 8) {
#pragma unroll
                    for (int nb = 0; nb < 4; ++nb) af[(ks + 1) & 1][nb] = *(const LAS bf16x8*)(wb + (128 + nb * 32) * WKS + 32 * (ks + 1)); }
#pragma unroll
                for (int nb = 0; nb < 4; ++nb) acc[nb] = __builtin_amdgcn_mfma_f32_32x32x16_bf16(af[ks & 1][nb], __builtin_bit_cast(bf16x8, bk[ks]), acc[nb], 0, 0, 0);
                asm volatile("" : "+v"(wb) : "v"(acc[0][0]));
            }
            bf16_t* vo = WSP(bf16_t, WS_V) + ((size_t)(b * NH + h) * SEQ + (tblk * 32 & 4095)) * VH;
            store_rows_via_lds<4, 272>(stg, acc[0], acc[1], acc[2], acc[3], rl, nullptr, vo, VH, ln_);
        }
        __syncthreads();
    }
#endif
}

constexpr int KST = 400, VST = 320;
constexpr int ATT_KOFF = 0, ATT_VOFF = 2 * 64 * KST, ATT_BYTES = ATT_VOFF + 2 * 64 * VST;
static_assert(ATT_BYTES <= RING_BYTES && 64 * KST == 25 * 1024 && 64 * VST == 20 * 1024, "attention LDS: a K tile is 25 and a V tile 20 LDS-DMA pieces of 1 KiB");
__device__ __forceinline__ float max3f(float a, float b, float c) { float r; asm("v_max3_f32 %0, %1, %2, %3" : "=v"(r) : "v"(a), "v"(b), "v"(c)); return r; }
__device__ __forceinline__ float max2f(float a, float b) { float r; asm("v_max_f32_e32 %0, %1, %2" : "=v"(r) : "v"(a), "v"(b)); return r; }
__device__ __forceinline__ void glds16s(const void* sbase, unsigned voff, unsigned lds_dst) { unsigned keep;
    asm volatile("s_mov_b32 %0, m0\n\ts_mov_b32 m0, %3\n\ts_nop 4\n\tglobal_load_lds_dwordx4 %1, %2\n\ts_mov_b32 m0, %0" : "=&s"(keep) : "v"(voff), "s"(sbase), "s"(lds_dst) : "memory"); }
__device__ __forceinline__ void glds16(const void* gsrc, unsigned lds_dst) { unsigned keep;
    asm volatile("s_mov_b32 %0, m0\n\ts_mov_b32 m0, %2\n\ts_nop 0\n\tglobal_load_lds_dwordx4 %1, off\n\ts_mov_b32 m0, %0" : "=&s"(keep) : "v"(gsrc), "s"(lds_dst) : "memory"); }
__device__ __forceinline__ void attn_unit(const Frame& F, int b, int h, int qb, bool bounded) {
    const int tid = F.tid, lane = F.lane, wid = F.wave, r = lane & 31, hi = lane >> 5;
    const bf16_t* Qh = WSP(const bf16_t, WS_Q) + (size_t)(b * NH + h) * SEQ * QKH;
    const char* Kh = (const char*)(WSP(const bf16_t, WS_K) + (size_t)(b * NH + h) * SEQ * QKH);
    const char* Vh = (const char*)(WSP(const bf16_t, WS_V) + (size_t)(b * NH + h) * SEQ * VH);
    const int q0 = qb * 256, qrow = q0 + 32 * wid + r, qmin = q0 + 32 * wid;
    bf16x8 qf[12];
#pragma unroll
    for (int ks = 0; ks < 12; ++ks) qf[ks] = __builtin_nontemporal_load((const bf16x8*)(Qh + (size_t)qrow * QKH + 16 * ks + 8 * hi));
    f32x16 o[4];
#pragma unroll
    for (int d = 0; d < 4; ++d) o[d] = f32x16{};
    float mrun = 0.f, lrun = 0.f; f32x16 negm = f32x16{};
    const int NT = (q0 + 256) / 64;
    unsigned soff[6];
#pragma unroll
    for (int i = 0; i < 6; ++i) { const int p = wid + 8 * i;
        if (p < 25) { const int q = 64 * p + lane, row = q / 25, cc = q % 25; soff[i] = (unsigned)(row * 384 + (cc < 24 ? cc : 23) * 16); }
        else { const int q = 64 * (p - 25) + lane, row = q / 20, cc = q % 20; soff[i] = (unsigned)(row * 256 + (cc < 16 ? cc : 15) * 16); } }
#define ATT_DMA(t, buf) do { const char* kt = Kh + (size_t)(t) * 64 * 384; const char* vt = Vh + (size_t)(t) * 64 * 256; \
        _Pragma("unroll") for (int i = 0; i < 6; ++i) { const int p = wid + 8 * i; if (p < 45) { \
            const char* src = (p < 25) ? kt : vt; const int dst = (p < 25) ? (ATT_KOFF + (buf) * 64 * KST + p * 1024) : (ATT_VOFF + (buf) * 64 * VST + (p - 25) * 1024); \
            unsigned so = soff[i]; asm volatile("" : "+v"(so));     \
            glds16s(src, so, (unsigned)__builtin_amdgcn_readfirstlane((int)(lds0 + dst))); } } } while (0)
    const unsigned lds0 = (unsigned)(uintptr_t)F.lds;
#define ATT_WAIT_BAR() asm volatile("s_waitcnt vmcnt(0) lgkmcnt(0)\n\ts_barrier" ::: "memory")
    ATT_DMA(0, 0); ATT_WAIT_BAR();
#pragma unroll
    for (int ks = 0; ks < 12; ++ks) asm volatile("" : "+v"(qf[ks]));
    const int i16 = lane & 15, q4 = i16 >> 2, p4 = i16 & 3, g2 = (lane >> 4) & 1;
    const int klane = r * KST + 16 * hi, vlane = (4 * hi + q4) * VST + (16 * g2 + 4 * p4) * 2;
    for (int t = 0; t < NT; ++t) {
        const int buf = t & 1;
        if (t + 1 < NT) ATT_DMA(t + 1, buf ^ 1);
        if (64 * t <= qmin + 31) {
            const LAS unsigned char* kb = F.lds + ATT_KOFF + buf * 64 * KST + klane; asm volatile("" : "+v"(kb));
            f32x16 p0 = negm, p1 = negm;
            bf16x8 kf[3][4];
#define ATT_KLOAD(G) do { _Pragma("unroll") for (int j = 0; j < 2; ++j) { kf[(G) % 3][2 * j] = *(const LAS bf16x8*)(kb + 32 * (2 * (G) + j)); kf[(G) % 3][2 * j + 1] = *(const LAS bf16x8*)(kb + 32 * KST + 32 * (2 * (G) + j)); } } while (0)
            ATT_KLOAD(0); ATT_KLOAD(1);
#pragma unroll
            for (int g = 0; g < 6; ++g) {
                if (g + 2 < 6) ATT_KLOAD(g + 2);
#pragma unroll
                for (int j = 0; j < 2; ++j) { p0 = __builtin_amdgcn_mfma_f32_32x32x16_bf16(kf[g % 3][2 * j], qf[2 * g + j], p0, 0, 0, 0); p1 = __builtin_amdgcn_mfma_f32_32x32x16_bf16(kf[g % 3][2 * j + 1], qf[2 * g + j], p1, 0, 0, 0); }
                asm volatile("" : "+v"(kb) : "v"(p0[0]));
            }
#undef ATT_KLOAD
            if (64 * t + 63 > qmin) {
#pragma unroll
                for (int rg = 0; rg < 16; ++rg) { const int key = 64 * t + crow(rg, hi); if (key > qrow) p0[rg] = -INFINITY; if (key + 32 > qrow) p1[rg] = -INFINITY; }
            }
            float mx = 0.f; bool resc = false;
            if (!bounded) {
            const float seed = fmaxf(p0[0], p1[0]);
            float mxa = max3f(seed, p0[1], p1[1]), mxb = max3f(seed, p0[2], p0[3]);
            mxa = max3f(mxa, p1[2], p1[3]);
#pragma unroll
            for (int rg = 4; rg < 16; rg += 2) { mxb = max3f(mxb, p0[rg], p0[rg + 1]); mxa = max3f(mxa, p1[rg], p1[rg + 1]); }
            mx = half_max(fmaxf(mxa, mxb));
            resc = __any(mx > 8.0f);
            }
            float ps = 0.f;
#pragma unroll
            for (int rg = 0; rg < 16; ++rg) { p0[rg] = __builtin_amdgcn_exp2f(p0[rg]); p1[rg] = __builtin_amdgcn_exp2f(p1[rg]); ps += p0[rg]; ps += p1[rg]; }
            lrun += ps;
            bf16x8 pf[4];
#pragma unroll
            for (int s = 0; s < 2; ++s) {
                u32x4 w; w.x = pk2(p0[8 * s], p0[8 * s + 1]); w.y = pk2(p0[8 * s + 2], p0[8 * s + 3]); w.z = pk2(p0[8 * s + 4], p0[8 * s + 5]); w.w = pk2(p0[8 * s + 6], p0[8 * s + 7]); pf[s] = __builtin_bit_cast(bf16x8, w);
                u32x4 w2; w2.x = pk2(p1[8 * s], p1[8 * s + 1]); w2.y = pk2(p1[8 * s + 2], p1[8 * s + 3]); w2.z = pk2(p1[8 * s + 4], p1[8 * s + 5]); w2.w = pk2(p1[8 * s + 6], p1[8 * s + 7]); pf[2 + s] = __builtin_bit_cast(bf16x8, w2); }
            const LAS unsigned char* vb = F.lds + ATT_VOFF + buf * 64 * VST + vlane; asm volatile("" : "+v"(vb));
            s16x4 vl[2][4], vh[2][4];
#pragma unroll
            for (int d = 0; d < 4; ++d) { vl[0][d] = vtr(vb + 64 * d); vh[0][d] = vtr(vb + 8 * VST + 64 * d); }
#pragma unroll
            for (int kk = 0; kk < 4; ++kk) {
                if (kk + 1 < 4) {
#pragma unroll
                    for (int d = 0; d < 4; ++d) { vl[(kk + 1) & 1][d] = vtr(vb + (16 * (kk + 1)) * VST + 64 * d); vh[(kk + 1) & 1][d] = vtr(vb + (16 * (kk + 1) + 8) * VST + 64 * d); } }
#pragma unroll
                for (int d = 0; d < 4; ++d) { const s16x4 lo = vl[kk & 1][d], hh = vh[kk & 1][d];
                    const bf16x8 vf = {lo[0], lo[1], lo[2], lo[3], hh[0], hh[1], hh[2], hh[3]};
                    o[d] = __builtin_amdgcn_mfma_f32_32x32x16_bf16(vf, pf[kk], o[d], 0, 0, 0); }
                asm volatile("" : "+v"(vb) : "v"(o[0][0]));
            }
            if (resc) {
                const float dl = fmaxf(mx, 0.f), alpha = __builtin_amdgcn_exp2f(-dl); mrun += dl; lrun *= alpha;
#pragma unroll
                for (int rg = 0; rg < 16; ++rg) negm[rg] = -mrun;
#pragma unroll
                for (int d = 0; d < 4; ++d)
#pragma unroll
                    for (int rg = 0; rg < 16; ++rg) o[d][rg] *= alpha;
            }
        }
        ATT_WAIT_BAR();
    }
#undef ATT_DMA
#undef ATT_WAIT_BAR
    lrun = half_sum(lrun);
    const float rinv = __builtin_amdgcn_rcpf(lrun);
    bf16_t* orow = WSP(bf16_t, WS_H) + (size_t)(b * SEQ + qrow) * DM + SGU_W + VH * h;
#pragma unroll
    for (int d = 0; d < 4; ++d)
#pragma unroll
        for (int g4 = 0; g4 < 4; ++g4) { u32x2 w; w.x = pk2(o[d][4 * g4] * rinv, o[d][4 * g4 + 1] * rinv); w.y = pk2(o[d][4 * g4 + 2] * rinv, o[d][4 * g4 + 3] * rinv);
            *(u32x2*)(orow + 32 * d + 8 * g4 + 4 * hi) = w; }
}
__device__ __forceinline__ void attn_phase(const Frame& F0, int l) {
    Frame F = phase_frame(F0);
    float gq = 0.f, gk = 0.f;
#pragma unroll
    for (int i = 0; i < 3; ++i) { gq = fmaxf(gq, fabsf(FIN(float, I_QN)[l * QKH + F.lane + 64 * i])); gk = fmaxf(gk, fabsf(FIN(float, I_KN)[l * QKH + F.lane + 64 * i])); }
    gq = wave_max(gq, F.lane); gk = wave_max(gk, F.lane);
    const bool bounded = __builtin_amdgcn_readfirstlane(__builtin_bit_cast(int, gq * gk)) <= __builtin_bit_cast(int, 2.0f);
    for (int pr = F.vcu; pr < NB * NH * 8; pr += F.G) {
        const int bh = pr >> 3, j = pr & 7;
        attn_unit(F, bh >> 2, bh & 3, 15 - j, bounded);
        attn_unit(F, bh >> 2, bh & 3, j, bounded);
    }
}

constexpr int NPHASE = 21;
struct Args { const void* in[25]; float* out; unsigned char* ws; int ph_lo, ph_hi; };
__global__ void __launch_bounds__(NTHR, 2) fwd_kernel(Args args) {
    extern __shared__ __attribute__((aligned(16))) unsigned char lds_raw[];
    Frame F0;
    F0.lds = (LAS unsigned char*)lds_raw;
    F0.tid = threadIdx.x; F0.lane = F0.tid & 63; F0.wave = __builtin_amdgcn_readfirstlane(F0.tid >> 6);
    F0.G = gridDim.x; { const int bx = blockIdx.x; F0.vcu = (F0.G % 8 == 0) ? (bx % 8) * (F0.G / 8) + bx / 8 : bx; }
    F0.out = (GAS float*)args.out; F0.ws = (GAS unsigned char*)args.ws;
    const Frame& F = F0;
    volatile LAS unsigned* MISC = (volatile LAS unsigned*)(F0.lds + MISC_OFF);
    if (F0.tid < 64) MISC[F0.tid] = 0u;
    __syncthreads();
    const int lo = args.ph_lo, hi = args.ph_hi;
    const bool one = (MK_N_LAUNCHES == 1) || (hi - lo) > 1;
    XcdBarrier bar; bar.bar = (unsigned*)(F0.ws + WS_CTL) + CW_BAR; bar.x = 0; bar.st = nullptr; bar.w = F0.wave;
    if (one) bar = xcd_barrier_post((unsigned*)(F0.ws + WS_CTL) + CW_BAR, MISC + 8, F0.wave);
#ifndef PH_MASK
#define PH_MASK 0xFFFFFFFFu
#endif
#define EN(j) (((PH_MASK) >> (j)) & 1u)
#ifndef REPEAT_MASK
#define REPEAT_MASK 0u
#endif
#define NREP(j) ((((REPEAT_MASK) >> (j)) & 1u) ? 2 : 1)
#if MK_N_LAUNCHES == 1
#define IN(k) true
#else
#define IN(k) (lo <= (k) && (k) < hi)
#endif
#define SEAM(k) do { if (IN(k) && IN((k) + 1)) xcd_barrier(bar); } while (0)
    const float* MOD = WSP(const float, WS_MOD);

    if (EN(0) && IN(0)) { for (int rep_ = 0; rep_ < NREP(0); ++rep_) { if (rep_) xcd_barrier(bar);  p0_prologue(F0);  } } SEAM(0);
#pragma unroll 1
    for (int l = 0; l < 2; ++l) {
        const int pb = 1 + 8 * l;
        const float* mod_l = MOD + (size_t)l * NB * (NMOD * DM);
        bf16_t* const XB = WSP(bf16_t, WS_XB);
        if (EN(1) && IN(pb)) { for (int rep_ = 0; rep_ < NREP(1); ++rep_) { if (rep_) xcd_barrier(bar);  if (l == 0) norm_phase<false, true, false>(F0, FIN(float, I_X), FIN(float, I_NMIX), mod_l + 0 * DM, mod_l + 1 * DM, WSP(bf16_t, WS_H), 0); else norm_phase<false, true, true>(F0, XB, FIN(float, I_NMIX) + DM, mod_l + 0 * DM, mod_l + 1 * DM, WSP(bf16_t, WS_H), 0);  } } SEAM(pb);
        if (EN(2) && IN(pb + 1)) { for (int rep_ = 0; rep_ < NREP(2); ++rep_) { if (rep_) xcd_barrier(bar);
            const Frame F = phase_frame(F0); pg8::DenseSched S; S.so.init(NTOK / 256, D_INP / 256, F.G, (int)blockIdx.x); S.A = (const char*)WSP(bf16_t, WS_H); S.Bt = (const char*)(F.ws + WS_WIN) + (size_t)l * D_INP * DM; S.tstep = (size_t)256 * DM;
            EpiInProj E{WSP(bf16_t, WS_U), WSP(bf16_t, WS_GV), WSP(bf16_t, WS_CQ), WSP(bf16_t, WS_CKV), WSP(bf16_t, WS_KR), WSP(const float, WS_SA), WSP(const float, WS_SBIN) + l * D_INP};
            pg8::gemm_phase<EpiInProj, pg8::DenseSched, true, true>(F.lds, F.wave, DM / 2, DM / 2, S, E);
         } } SEAM(pb + 1);
        if (EN(3) && IN(pb + 2)) { for (int rep_ = 0; rep_ < NREP(3); ++rep_) { if (rep_) xcd_barrier(bar);  mid_phase(F0, l);  } } SEAM(pb + 2);
        if (EN(4) && IN(pb + 3)) { for (int rep_ = 0; rep_ < NREP(4); ++rep_) { if (rep_) xcd_barrier(bar);  attn_phase(F0, l);  } } SEAM(pb + 3);
        if (EN(5) && IN(pb + 4)) {
            const Frame F = phase_frame(F0); pg8::DenseSched S; S.so.init(NTOK / 256, DM / 256, F.G, (int)blockIdx.x); S.A = (const char*)WSP(bf16_t, WS_H); S.Bt = (const char*)(WSP(bf16_t, WS_WOUT) + (size_t)l * DM * DM); S.tstep = (size_t)256 * DM * 2;
            if (l == 0) { EpiResidB<true> E{FIN(float, I_X), XB, mod_l + 2 * DM}; pg8::gemm_phase<EpiResidB<true>, pg8::DenseSched, true>(F.lds, F.wave, DM, DM, S, E); }
            else { EpiResidB<false> E{XB, XB, mod_l + 2 * DM}; pg8::gemm_phase<EpiResidB<false>, pg8::DenseSched, true>(F.lds, F.wave, DM, DM, S, E); }
        } SEAM(pb + 4);
        if (l == 0) {
            if (EN(1) && IN(6)) { for (int rep_ = 0; rep_ < NREP(1); ++rep_) { if (rep_) xcd_barrier(bar);  norm_phase<false, true, true>(F0, XB, FIN(float, I_NFFN), mod_l + 3 * DM, mod_l + 4 * DM, WSP(bf16_t, WS_H), 0);  } } SEAM(6);
            if (EN(6) && IN(7)) { for (int rep_ = 0; rep_ < NREP(6); ++rep_) { if (rep_) xcd_barrier(bar);
                const Frame F = phase_frame(F0); pg8::DenseSched S; S.so.init(NTOK / 256, 5632 / 256, F.G, (int)blockIdx.x); S.A = (const char*)WSP(bf16_t, WS_H); S.Bt = (const char*)WSP(bf16_t, WS_WFU); S.tstep = (size_t)256 * DM;
                EpiSwiGLU8 E{WSP(bf16_t, WS_ACT), WSP(const float, WS_SA), WSP(const float, WS_SB), nullptr};
                pg8::gemm_phase<EpiSwiGLU8, pg8::DenseSched, true, true>(F.lds, F.wave, DM / 2, DM / 2, S, E);
             } } SEAM(7);
            if (EN(7) && IN(8)) {
                const Frame F = phase_frame(F0); pg8::DenseSched S; S.so.init(NTOK / 256, DM / 256, F.G, (int)blockIdx.x); S.A = (const char*)WSP(bf16_t, WS_ACT); S.Bt = (const char*)WSP(bf16_t, WS_WFD); S.tstep = (size_t)256 * DFF * 2;
                EpiResidB<false> E{XB, XB, mod_l + 5 * DM};
                pg8::gemm_phase<EpiResidB<false>, pg8::DenseSched, true>(F.lds, F.wave, DFF, DFF, S, E);
            } SEAM(8);
        } else {
            if (EN(8) && IN(14)) { for (int rep_ = 0; rep_ < NREP(8); ++rep_) { if (rep_) xcd_barrier(bar);  norm_phase<true, true, true>(F0, XB, FIN(float, I_NFFN) + DM, mod_l + 3 * DM, mod_l + 4 * DM, WSP(bf16_t, WS_H), 0);  } } SEAM(14);
            if (EN(9) && IN(15)) { for (int rep_ = 0; rep_ < NREP(9); ++rep_) { if (rep_) xcd_barrier(bar);  route_phase(F0);  } } SEAM(15);
#pragma unroll 1
            for (int s = 0; s < 2; ++s) {
                if (EN(10) && IN(16 + 2 * s)) { for (int rep_ = 0; rep_ < NREP(10); ++rep_) { if (rep_) xcd_barrier(bar);
                    if (s == 1 && rep_ == 0) moe_tail_reduce<false>(F0, 0, mod_l + 5 * DM);
                    const Frame F = phase_frame(F0); const int n = moe_prep(F, s, 0);
                    pg8::MoeSched<true> S; S.ul = (const LAS int*)(F.lds + LDS_UL_OFF); S.idx = (const LAS int*)(F.lds + LDS_IDX_OFF); S.n = n; S.aux0 = 0; S.A = (const char*)WSP(bf16_t, WS_H); S.Bt = (const char*)WSP(bf16_t, WS_WMU);
                    S.tstepA = 0; S.tstepB = (size_t)256 * DM; S.estride = (size_t)5632 * DM;
                    EpiSwiGLU8 E{WSP(bf16_t, WS_ACT), WSP(const float, WS_RSA) + s * SLOTROWS, WSP(const float, WS_SB) + 5632, nullptr};
                    pg8::gemm_phase<EpiSwiGLU8, pg8::MoeSched<true>, true, true>(F.lds, F.wave, DM / 2, DM / 2, S, E);
                 } } SEAM(16 + 2 * s);
                if (EN(11) && IN(17 + 2 * s)) {
                    const Frame F = phase_frame(F0); const int n = moe_prep(F, s, 1); const int nt2 = moe_prep(F, s, 2);
                    {
                        pg8::MoeSched<false> S; S.ul = (const LAS int*)(F.lds + LDS_UL_OFF); S.idx = nullptr; S.n = n; S.aux0 = 0; S.A = (const char*)WSP(bf16_t, WS_ACT); S.Bt = (const char*)WSP(bf16_t, WS_WMD);
                        S.tstepA = (size_t)256 * DFF * 2; S.tstepB = (size_t)256 * DFF * 2; S.estride = (size_t)DM * DFF * 2;
                        if (s == 0) { EpiMoeDownB<false> E{XB, (float*)F.out, mod_l + 5 * DM, WSP(const int, WS_RMAP), WSP(const float, WS_RGATE)}; pg8::gemm_phase<EpiMoeDownB<false>, pg8::MoeSched<false>, true>(F.lds, F.wave, DFF, DFF, S, E); }
                        else { EpiMoeDownB<true> E{XB, (float*)F.out, mod_l + 5 * DM, WSP(const int, WS_RMAP) + SLOTROWS, WSP(const float, WS_RGATE) + SLOTROWS}; pg8::gemm_phase<EpiMoeDownB<true>, pg8::MoeSched<false>, true>(F.lds, F.wave, DFF, DFF, S, E); }
                    }
                    {
                        pg8::MoeSched<false> S; S.ul = (const LAS int*)(F.lds + LDS_UL_OFF + 256); S.idx = nullptr; S.n = nt2; S.aux0 = 0; S.A = (const char*)WSP(bf16_t, WS_ACT); S.Bt = (const char*)WSP(bf16_t, WS_WMD);
                        S.tstepA = (size_t)256 * DFF * 2; S.tstepB = (size_t)256 * DFF * 2; S.estride = (size_t)DM * DFF * 2;
                        EpiPartial E{(unsigned char*)F.ws};
                        pg8::gemm_phase<EpiPartial, pg8::MoeSched<false>, true>(F.lds, F.wave, 256, DFF, S, E);
                    }
                } SEAM(17 + 2 * s);
            }
            if (EN(11) && IN(20)) { moe_tail_reduce<true>(F0, 1, mod_l + 5 * DM); }
        }
    }
#undef IN
#undef SEAM
}

extern "C" void kernel_launch(void* const* d_in, const int* in_sizes, int n_in, void* d_out, int out_size, void* d_ws, size_t ws_size, hipStream_t stream) {
    static int grid = 0;
    if (grid == 0) {
        if (n_in != 25 || out_size != NTOK * DM || ws_size < WS_END) { fprintf(stderr, "kernel_launch: unexpected shapes (n_in %d, out %d, ws %zu)\n", n_in, out_size, ws_size); grid = -1; return; }
        int dev = 0, cus = 0, per_cu = 0;
        if (hipGetDevice(&dev) != hipSuccess || hipDeviceGetAttribute(&cus, hipDeviceAttributeMultiprocessorCount, dev) != hipSuccess) { grid = -1; return; }
        if (hipFuncSetAttribute((const void*)fwd_kernel, hipFuncAttributeMaxDynamicSharedMemorySize, LDS_BYTES) != hipSuccess) { fprintf(stderr, "kernel_launch: hipFuncSetAttribute failed\n"); grid = -1; return; }
        if (hipOccupancyMaxActiveBlocksPerMultiprocessor(&per_cu, (const void*)fwd_kernel, NTHR, LDS_BYTES) != hipSuccess || per_cu < 1) fprintf(stderr, "kernel_launch: occupancy query reports %d\n", per_cu);
        (void)hipGetLastError();
        grid = cus;
    }
    if (grid < 0) return;
    if (hipMemsetAsync((char*)d_ws + WS_CTL, 0, CTL_ZERO_BYTES, stream) != hipSuccess) return;
    Args a{};
    for (int i = 0; i < 25; ++i) a.in[i] = d_in[i];
    a.out = (float*)d_out; a.ws = (unsigned char*)d_ws;
#if MK_N_LAUNCHES == 1
    a.ph_lo = 0; a.ph_hi = NPHASE;
    hipLaunchKernelGGL(fwd_kernel, dim3(grid), dim3(NTHR), LDS_BYTES, stream, a);
#else
    for (int k = 0; k < NPHASE; ++k) { a.ph_lo = k; a.ph_hi = k + 1; hipLaunchKernelGGL(fwd_kernel, dim3(grid), dim3(NTHR), LDS_BYTES, stream, a); }
#endif
}
```
